# Optimizing an MI355X kernel written in HIP

```python
import jax
import jax.numpy as jnp
from jax import lax
import numpy as np

D_MODEL = 1024
BATCH = 32
SEQ = 256
DEPTH = 1
DEC_BATCH = 2
DEC_SEQ = 2048
PAST_LEN = 512

GRID_W = 64
N_HEADS = 8
HEAD_DIM = 64
D_NA = N_HEADS * HEAD_DIM
D_POOL = 512
POOL_WINDOWS = (2, 4, 8, 16)
N_POOL_GROUPS = len(POOL_WINDOWS)
POOL_GROUP = D_POOL // N_POOL_GROUPS
WIN_H = 8
WIN_W = 16
QB_W = 16
KB_W = 2 * QB_W
NQB = GRID_W // QB_W
D_FF = 2816
CONV_W = 3
Q_BLOCK = 128
EPS = 1e-6
NEG_INF = -1e30
D_IN = D_POOL + 3 * D_NA + 2 * D_MODEL
IN_SPLITS = (D_POOL, D_POOL + D_NA, D_POOL + 2 * D_NA, D_POOL + 3 * D_NA, D_POOL + 3 * D_NA + D_MODEL)

kernel_name = "hybrid_pool_natten_dit_step"


def _rms(x, g):
    xf = x.astype(jnp.float32)
    y = xf * lax.rsqrt(jnp.mean(xf * xf, axis=-1, keepdims=True) + EPS)
    return (y * g.astype(jnp.float32)).astype(x.dtype)


def _modulation(cond, w_mod, b_mod):
    m = (jax.nn.silu(cond) @ w_mod + b_mod)[:, None, :]
    return jnp.split(m, 6, axis=-1)


def _modulated_norm(x, g, shift, scale):
    return _rms(x, g) * (1 + scale) + shift


def _mixer_inputs(h, w_in, q_g, k_g):
    B, L, _ = h.shape
    z = h @ w_in
    p, q, k, v, gp, gn = jnp.split(z, IN_SPLITS, axis=-1)

    def heads(t):
        return t.reshape(B, L, N_HEADS, HEAD_DIM).transpose(0, 2, 1, 3)

    q = _rms(heads(q), q_g)
    k = _rms(heads(k), k_g)
    return p, q, k, heads(v), gp, gn


def _pool_mixer(p, w_pool, s_pool):
    B, L, _ = p.shape
    pf = p.astype(jnp.float32)
    cs = jnp.concatenate([jnp.zeros((B, 1, D_POOL), jnp.float32), jnp.cumsum(pf, axis=1)], axis=1)
    t = np.arange(L)
    groups = []
    for gi, w in enumerate(POOL_WINDOWS):
        lo = np.clip(t - w // 2, 0, L)
        hi = np.clip(t + w - w // 2, 0, L)
        cnt = jnp.asarray((hi - lo).astype(np.float32))[None, :, None]
        sl = slice(gi * POOL_GROUP, (gi + 1) * POOL_GROUP)
        seg = cs[:, :, sl]
        groups.append((seg[:, hi] - seg[:, lo]) / cnt - pf[:, :, sl])
    pooled = jnp.stack(groups, axis=2).astype(p.dtype)
    mixed = jnp.einsum("blgc,gcd->blgd", pooled, w_pool).reshape(B, L, D_POOL)
    return mixed * s_pool


def _context_attention(q, k, v):
    B, H, Lc, dh = q.shape
    nb = Lc // Q_BLOCK
    scale = HEAD_DIM ** -0.5
    qb = q.reshape(B, H, nb, Q_BLOCK, dh).transpose(2, 0, 1, 3, 4)

    def blk(qi):
        s = jnp.einsum("bhqd,bhkd->bhqk", qi, k).astype(jnp.float32) * scale
        pr = jax.nn.softmax(s, axis=-1).astype(v.dtype)
        return jnp.einsum("bhqk,bhkd->bhqd", pr, v)

    o = lax.map(blk, qb)
    return o.transpose(1, 3, 0, 2, 4).reshape(B, Lc, H * dh)


def _na_geometry(rows):
    kh = min(WIN_H, rows)
    r = np.arange(rows)
    row_start = np.clip(r - kh // 2, 0, rows - kh)
    row_idx = row_start[:, None] + np.arange(kh)[None, :]
    c0 = np.arange(NQB) * QB_W
    band_start = np.clip(c0 - WIN_W // 2, 0, GRID_W - KB_W)
    col_idx = band_start[:, None] + np.arange(KB_W)[None, :]
    qc = c0[:, None] + np.arange(QB_W)[None, :]
    win_start = np.clip(qc - WIN_W // 2, 0, GRID_W - WIN_W)
    kc = col_idx[:, None, :]
    valid = (kc >= win_start[:, :, None]) & (kc < win_start[:, :, None] + WIN_W)
    dr_idx = row_idx - r[:, None] + (WIN_H - 1)
    dc_idx = np.clip(kc - qc[:, :, None] + (WIN_W - 1), 0, 2 * WIN_W - 2)
    return kh, row_idx, col_idx, valid, dr_idx, dc_idx


def _latent_attention(q, k, v, k_ctx, v_ctx, rpb):
    B, H, L, dh = q.shape
    rows = L // GRID_W
    kh, row_idx, col_idx, valid, dr_idx, dc_idx = _na_geometry(rows)
    nk = kh * KB_W
    scale = HEAD_DIM ** -0.5
    qb = q.reshape(B, H, rows, NQB, QB_W, dh)

    def band(t):
        t = t.reshape(B, H, rows, GRID_W, dh)
        t = jnp.take(t, row_idx, axis=2)
        t = jnp.take(t, col_idx, axis=4)
        return t.transpose(0, 1, 2, 4, 3, 5, 6).reshape(B, H, rows, NQB, nk, dh)

    kb, vb = band(k), band(v)
    bias = rpb[:, dr_idx[:, None, None, :, None], dc_idx[None, :, :, None, :]]
    bias = bias.reshape(H, rows, NQB, QB_W, nk).astype(jnp.float32)
    mask = np.broadcast_to(valid[:, :, None, :], (NQB, QB_W, kh, KB_W)).reshape(NQB, QB_W, nk)
    s_loc = jnp.einsum("bhrnqd,bhrnkd->bhrnqk", qb, kb).astype(jnp.float32) * scale + bias
    s_loc = jnp.where(mask, s_loc, NEG_INF)
    s_ctx = jnp.einsum("bhrnqd,bhkd->bhrnqk", qb, k_ctx).astype(jnp.float32) * scale
    prob = jax.nn.softmax(jnp.concatenate([s_loc, s_ctx], axis=-1), axis=-1).astype(v.dtype)
    o = (jnp.einsum("bhrnqk,bhrnkd->bhrnqd", prob[..., :nk], vb)
         + jnp.einsum("bhrnqk,bhkd->bhrnqd", prob[..., nk:], v_ctx))
    return o.transpose(0, 2, 3, 4, 1, 5).reshape(B, L, H * dh)


def _merge(pool_out, na_out, gp, gn, w_pool_proj, w_na_proj, w_o):
    a = pool_out @ w_pool_proj
    b = na_out @ w_na_proj
    return (jax.nn.sigmoid(gp) * a + jax.nn.sigmoid(gn) * b) @ w_o


def _conv_ffn(h, w_up, conv_w, conv_b, w_down):
    u = h @ w_up
    up = jnp.pad(u, ((0, 0), (1, 1), (0, 0)))
    u = up[:, :-2] * conv_w[0] + up[:, 1:-1] * conv_w[1] + up[:, 2:] * conv_w[2] + conv_b
    a, g = jnp.split(u, 2, axis=-1)
    return (jax.nn.silu(a) * g) @ w_down


def _layer(x, cond, attend, norm_mix_g, norm_ffn_g, w_mod, b_mod, w_in, q_norm_g, k_norm_g,
           pool_w, pool_scale, w_pool_proj, w_na_proj, w_o, w_up, ffn_conv_w, ffn_conv_b, w_down):
    sa, ca, ga, sf, cf, gf = _modulation(cond, w_mod, b_mod)
    h = _modulated_norm(x, norm_mix_g, sa, ca)
    p, q, k, v, gp, gn = _mixer_inputs(h, w_in, q_norm_g, k_norm_g)
    na = attend(q, k, v)
    pool = _pool_mixer(p, pool_w, pool_scale)
    x = x + ga * _merge(pool, na, gp, gn, w_pool_proj, w_na_proj, w_o)
    h = _modulated_norm(x, norm_ffn_g, sf, cf)
    x = x + gf * _conv_ffn(h, w_up, ffn_conv_w, ffn_conv_b, w_down)
    return x, k, v


def setup_inputs(seed: int = 0) -> dict:
    key = jax.random.key(seed)
    ks = jax.random.split(key, 24)

    def nrm(k, shape, scale):
        return jax.random.normal(k, shape, jnp.float32) * scale

    return {
        "x_prompt": nrm(ks[0], (BATCH, SEQ, D_MODEL), 1.0),
        "x_sample": nrm(ks[1], (DEC_BATCH, DEC_SEQ, D_MODEL), 1.0),
        "cache_k": nrm(ks[2], (DEC_BATCH, DEPTH, N_HEADS, PAST_LEN, HEAD_DIM), 1.0),
        "cache_v": nrm(ks[3], (DEC_BATCH, DEPTH, N_HEADS, PAST_LEN, HEAD_DIM), 1.0),
        "c": nrm(ks[4], (DEC_BATCH, D_MODEL), 1.0),
        "c_ctx": nrm(ks[5], (D_MODEL,), 1.0),
        "norm_mix_g": 1.0 + nrm(ks[6], (DEPTH, D_MODEL), 0.1),
        "norm_ffn_g": 1.0 + nrm(ks[7], (DEPTH, D_MODEL), 0.1),
        "w_mod": nrm(ks[8], (DEPTH, D_MODEL, 6 * D_MODEL), 0.5 * D_MODEL ** -0.5),
        "b_mod": nrm(ks[9], (DEPTH, 6 * D_MODEL), 0.02),
        "w_in": nrm(ks[10], (DEPTH, D_MODEL, D_IN), D_MODEL ** -0.5),
        "q_norm_g": 1.0 + nrm(ks[11], (DEPTH, HEAD_DIM), 0.1),
        "k_norm_g": 1.0 + nrm(ks[12], (DEPTH, HEAD_DIM), 0.1),
        "pool_w": nrm(ks[13], (DEPTH, N_POOL_GROUPS, POOL_GROUP, POOL_GROUP), POOL_GROUP ** -0.5),
        "pool_scale": 1.0 + nrm(ks[14], (DEPTH, D_POOL), 0.1),
        "na_rpb": nrm(ks[15], (DEPTH, N_HEADS, 2 * WIN_H - 1, 2 * WIN_W - 1), 0.1),
        "w_pool_proj": nrm(ks[16], (DEPTH, D_POOL, D_MODEL), D_POOL ** -0.5),
        "w_na_proj": nrm(ks[17], (DEPTH, D_NA, D_MODEL), D_NA ** -0.5),
        "w_o": nrm(ks[18], (DEPTH, D_MODEL, D_MODEL), D_MODEL ** -0.5),
        "w_up": nrm(ks[19], (DEPTH, D_MODEL, 2 * D_FF), D_MODEL ** -0.5),
        "ffn_conv_w": nrm(ks[20], (DEPTH, CONV_W, 2 * D_FF), CONV_W ** -0.5),
        "ffn_conv_b": nrm(ks[21], (DEPTH, 2 * D_FF), 0.02),
        "w_down": nrm(ks[22], (DEPTH, D_FF, D_MODEL), D_FF ** -0.5),
    }


def reference(x_prompt, x_sample, cache_k, cache_v, c, c_ctx, norm_mix_g, norm_ffn_g, w_mod, b_mod,
              w_in, q_norm_g, k_norm_g, pool_w, pool_scale, na_rpb, w_pool_proj, w_na_proj, w_o,
              w_up, ffn_conv_w, ffn_conv_b, w_down):
    x = x_prompt
    ks, vs = [], []
    for l in range(DEPTH):
        x, k, v = _layer(x, c_ctx[None, :], _context_attention,
                         norm_mix_g[l], norm_ffn_g[l], w_mod[l], b_mod[l], w_in[l], q_norm_g[l],
                         k_norm_g[l], pool_w[l], pool_scale[l], w_pool_proj[l], w_na_proj[l], w_o[l],
                         w_up[l], ffn_conv_w[l], ffn_conv_b[l], w_down[l])
        ks.append(k)
        vs.append(v)
    y_prompt = x
    new_k = jnp.stack(ks, axis=1)
    new_v = jnp.stack(vs, axis=1)

    x = x_sample
    for l in range(DEPTH):
        k_ctx, v_ctx, rpb = cache_k[:, l], cache_v[:, l], na_rpb[l]

        def attend(q, k, v, k_ctx=k_ctx, v_ctx=v_ctx, rpb=rpb):
            return _latent_attention(q, k, v, k_ctx, v_ctx, rpb)

        x, _, _ = _layer(x, c, attend,
                         norm_mix_g[l], norm_ffn_g[l], w_mod[l], b_mod[l], w_in[l], q_norm_g[l],
                         k_norm_g[l], pool_w[l], pool_scale[l], w_pool_proj[l], w_na_proj[l], w_o[l],
                         w_up[l], ffn_conv_w[l], ffn_conv_b[l], w_down[l])
    y_sample = x
    return (y_prompt, y_sample, new_k, new_v)
```

```cpp
#include <hip/hip_runtime.h>
#include <cstdio>
#include <cstdint>
#ifndef MK_PER_PHASE
#define MK_PER_PHASE 1
#endif
namespace pg8 {
#define PG8_LAS __attribute__((address_space(3)))
typedef unsigned short bf16_t;
typedef short bf16x8 __attribute__((ext_vector_type(8)));
typedef float f32x4 __attribute__((ext_vector_type(4)));
typedef unsigned u32x4 __attribute__((ext_vector_type(4)));
constexpr int BM = 256, BK = 64, HALF = 128, HTB = HALF * BK * 2  , STAGE_BYTES = 8 * HTB, NXCD = 8, WGM = 8;

__host__ __device__ __forceinline__ int lds_byte(int r, int c) { const int st = (r >> 4) * 2 + (c >> 5), rr = r & 15, cc = c & 31, ob = rr * 64 + cc * 2; return st * 1024 + (ob ^ (((ob >> 9) & 1) << 5)); }
__host__ __device__ __forceinline__ void stage_rc(int b, int& R, int& C) { const int st = b / 1024, sb = b % 1024, swz = sb ^ (((sb >> 9) & 1) << 5); R = (st >> 1) * 16 + swz / 64; C = (st & 1) * 32 + (swz % 64) / 2; }
__host__ __device__ __forceinline__ int perm32(int rho) { const int n = rho >> 4, i = rho & 15; return 8 * (i >> 2) + 4 * n + (i & 3); }

struct Unit { int pm, pn; };
struct Gemm { const bf16_t* A; const bf16_t* Bt; int M, N, K; };

struct StaticOrder {
    int nM, nN, nwg, G, c;
    __host__ __device__ void init(int M, int N, int G_, int c_) { nM = M / BM; nN = N / BM; nwg = nM * nN; G = G_; c = c_; }
    __host__ __device__ bool next(int i, Unit& u) const {
        const long L = (long)i * G + c; if (L >= nwg) return false;
        int wgid = (int)L; { const int q = nwg / NXCD, r = nwg % NXCD, xcd = wgid % NXCD, off = wgid / NXCD; wgid = (xcd < r ? xcd * (q + 1) : r * (q + 1) + (xcd - r) * q) + off; }
        const int nig = WGM * nN, gid = wgid / nig, fm = gid * WGM, gsz = (nM - fm) < WGM ? (nM - fm) : WGM;
        u.pm = fm + ((wgid % nig) % gsz); u.pn = (wgid % nig) / gsz; return true;
    }
    __device__ __forceinline__ void a_ready(const Unit&) const {}
    __device__ __forceinline__ void done(const Unit&) const {}
};

typedef float f32x2_t __attribute__((ext_vector_type(2))); typedef __bf16 bf16x2_t __attribute__((ext_vector_type(2)));
__device__ __forceinline__ unsigned cvt_pk_bf16(float lo, float hi) { f32x2_t v = {lo, hi}; bf16x2_t b = __builtin_convertvector(v, bf16x2_t); return __builtin_bit_cast(unsigned, b); }
__device__ __forceinline__ float bf_lo(unsigned w) { return __uint_as_float(w << 16); }
__device__ __forceinline__ float bf_hi(unsigned w) { return __uint_as_float(w & 0xffff0000u); }
__device__ __forceinline__ float sigmoidf_(float x) { return __builtin_amdgcn_rcpf(1.0f + __builtin_amdgcn_exp2f(-1.4426950408889634f * x)); }

struct EpiStoreBf16 {
    static constexpr bool PERM = true, AFTER_DRAIN = false;
    bf16_t* O; int ldc;
    __device__ __forceinline__ void operator()(const f32x4 (&acc)[2][2][4][2], const Unit& u, int wr, int wc, int fr, int fq) const {
        const int row0 = u.pm * BM + wr * 64 + fr, col0 = u.pn * BM + wc * 32 + 8 * fq;
#pragma unroll
        for (int ai = 0; ai < 2; ++ai)
#pragma unroll
            for (int m = 0; m < 4; ++m) { bf16_t* rowp = O + (size_t)(row0 + ai * HALF + m * 16) * ldc + col0;
#pragma unroll
                for (int bj = 0; bj < 2; ++bj) { const f32x4 v0 = acc[ai][bj][m][0], v1 = acc[ai][bj][m][1];
                    u32x4 w; w.x = cvt_pk_bf16(v0[0], v0[1]); w.y = cvt_pk_bf16(v0[2], v0[3]); w.z = cvt_pk_bf16(v1[0], v1[1]); w.w = cvt_pk_bf16(v1[2], v1[3]);
                    *(u32x4*)(rowp + bj * HALF) = w; } }
    }
};
struct EpiMerge {
    static constexpr bool PERM = true, AFTER_DRAIN = false;
    const bf16_t* T1; const bf16_t* Z; bf16_t* O;
    __device__ __forceinline__ void operator()(const f32x4 (&acc)[2][2][4][2], const Unit& u, int wr, int wc, int fr, int fq) const {
        const int row0 = u.pm * BM + wr * 64 + fr, col0 = u.pn * BM + wc * 32 + 8 * fq;
#pragma unroll
        for (int ai = 0; ai < 2; ++ai)
#pragma unroll
            for (int m = 0; m < 4; ++m) { const size_t row = (size_t)(row0 + ai * HALF + m * 16);
#pragma unroll
                for (int bj = 0; bj < 2; ++bj) { const int col = col0 + bj * HALF;
                    const u32x4 t = *(const u32x4*)(T1 + row * 1024 + col), gp = *(const u32x4*)(Z + row * 4096 + 2048 + col), gn = *(const u32x4*)(Z + row * 4096 + 3072 + col);
                    const f32x4 v0 = acc[ai][bj][m][0], v1 = acc[ai][bj][m][1];
                    u32x4 w;
                    w.x = cvt_pk_bf16(sigmoidf_(bf_lo(gp.x)) * bf_lo(t.x) + sigmoidf_(bf_lo(gn.x)) * v0[0], sigmoidf_(bf_hi(gp.x)) * bf_hi(t.x) + sigmoidf_(bf_hi(gn.x)) * v0[1]);
                    w.y = cvt_pk_bf16(sigmoidf_(bf_lo(gp.y)) * bf_lo(t.y) + sigmoidf_(bf_lo(gn.y)) * v0[2], sigmoidf_(bf_hi(gp.y)) * bf_hi(t.y) + sigmoidf_(bf_hi(gn.y)) * v0[3]);
                    w.z = cvt_pk_bf16(sigmoidf_(bf_lo(gp.z)) * bf_lo(t.z) + sigmoidf_(bf_lo(gn.z)) * v1[0], sigmoidf_(bf_hi(gp.z)) * bf_hi(t.z) + sigmoidf_(bf_hi(gn.z)) * v1[1]);
                    w.w = cvt_pk_bf16(sigmoidf_(bf_lo(gp.w)) * bf_lo(t.w) + sigmoidf_(bf_lo(gn.w)) * v1[2], sigmoidf_(bf_hi(gp.w)) * bf_hi(t.w) + sigmoidf_(bf_hi(gn.w)) * v1[3]);
                    *(u32x4*)(O + row * 1024 + col) = w; } }
    }
};
struct EpiResid {
    static constexpr bool PERM = false, AFTER_DRAIN = false;
    const float* base0; const float* base1; float* out; const float* gate;
    __device__ __forceinline__ void operator()(const f32x4 (&acc)[2][2][4][2], const Unit& u, int wr, int wc, int fr, int fq) const {
        const int trow = u.pm * BM, row0 = trow + wr * 64 + fr, col0 = u.pn * BM + wc * 32 + 4 * fq;
        const int mi = trow < 8192 ? 0 : 1 + ((trow - 8192) >> 11);
        const float* bp = trow < 8192 ? base0 : base1 - (size_t)8192 * 1024;
        f32x4 g[2][2];
#pragma unroll
        for (int bj = 0; bj < 2; ++bj)
#pragma unroll
            for (int n = 0; n < 2; ++n) g[bj][n] = *(const f32x4*)(gate + mi * 6144 + col0 + bj * HALF + n * 16);
#pragma unroll
        for (int ai = 0; ai < 2; ++ai)
#pragma unroll
            for (int m = 0; m < 4; ++m) { const size_t off = (size_t)(row0 + ai * HALF + m * 16) * 1024 + col0;
#pragma unroll
                for (int bj = 0; bj < 2; ++bj)
#pragma unroll
                    for (int n = 0; n < 2; ++n) { const f32x4 b = *(const f32x4*)(bp + off + bj * HALF + n * 16); *(f32x4*)(out + off + bj * HALF + n * 16) = b + g[bj][n] * acc[ai][bj][m][n]; } }
    }
};

template <class Epi, class Sched, bool ALIGN_EPI = false, bool SP2 = false>
__device__ __forceinline__ void gemm_phase(PG8_LAS unsigned char* lds, const Gemm g, const Sched& S, const Epi& E) {
    const int tid = threadIdx.x, wid = __builtin_amdgcn_readfirstlane(tid >> 6), lane = tid & 63, wr = wid >> 2, wc = wid & 3, fr = lane & 15, fq = lane >> 4;
    const int K = g.K, nt = K / BK;
    unsigned voffA[2], voffB[2];
#pragma unroll
    for (int i = 0; i < 2; ++i) { int R, C; stage_rc(tid * 16 + i * 8192, R, C); const int Rb = Epi::PERM ? ((R & ~31) + perm32(R & 31)) : R;
        voffA[i] = (unsigned)(R * K + C) * 2u; voffB[i] = (unsigned)(Rb * K + C) * 2u; }
    const size_t kstep = (size_t)(BK * 2);
    const size_t hstep = (size_t)HALF * K * 2;
    const size_t tstep = 2 * hstep;
    const unsigned ldsw = (unsigned)wid * 1024u;
    const int aoff = lds_byte(wr * 64 + fr, fq * 8), boff = lds_byte(wc * 32 + fr, fq * 8);
#define PG8_SA(b, h) (((b) * 2 + (h)) * HTB)
#define PG8_SB(b, h) ((4 + (b) * 2 + (h)) * HTB)
#define PG8_STAGE(bufoff, gbase, voff) do { _Pragma("unroll") for (int _i = 0; _i < 2; ++_i) \
        __builtin_amdgcn_global_load_lds((const unsigned*)((const char*)(gbase) + (voff)[_i]), (PG8_LAS unsigned*)(lds + (bufoff) + ldsw + _i * 8192), 16, 0, 0); } while (0)
#define PG8_LDA(dst, b, h) do { _Pragma("unroll") for (int m = 0; m < 4; ++m) _Pragma("unroll") for (int k = 0; k < 2; ++k) dst[m][k] = *(const PG8_LAS bf16x8*)(lds + PG8_SA(b, h) + aoff + m * 2048 + k * 1024); } while (0)
#define PG8_LDB(dst, b, h) do { _Pragma("unroll") for (int n = 0; n < 2; ++n) _Pragma("unroll") for (int k = 0; k < 2; ++k) dst[n][k] = *(const PG8_LAS bf16x8*)(lds + PG8_SB(b, h) + boff + n * 2048 + k * 1024); } while (0)
#define PG8_MMA(ai, bj, At, Bt) do { __builtin_amdgcn_s_setprio(1); _Pragma("unroll") for (int m = 0; m < 4; ++m) _Pragma("unroll") for (int n = 0; n < 2; ++n) _Pragma("unroll") for (int k = 0; k < 2; ++k) \
        acc[ai][bj][m][n] = __builtin_amdgcn_mfma_f32_16x16x32_bf16(Bt[n][k], At[m][k], acc[ai][bj][m][n], 0, 0, 0); __builtin_amdgcn_s_setprio(0); } while (0)
#define PG8_WAIT_V(n) asm volatile("s_waitcnt vmcnt(" #n ")" ::: "memory")
#define PG8_WAIT_L(n) asm volatile("s_waitcnt lgkmcnt(" #n ")" ::: "memory")
#define PG8_BAR __builtin_amdgcn_s_barrier()
#define PG8_SCHED __builtin_amdgcn_sched_barrier(0)
    Unit cur, nxt; int ui = 0;
    if (!S.next(0, cur)) return;
    f32x4 acc[2][2][4][2];
#pragma unroll
    for (int a = 0; a < 2; ++a)
#pragma unroll
        for (int b = 0; b < 2; ++b)
#pragma unroll
            for (int m = 0; m < 4; ++m)
#pragma unroll
                for (int n = 0; n < 2; ++n) acc[a][b][m][n] = (f32x4){0.f, 0.f, 0.f, 0.f};
    bf16x8 At[4][2], B0[2][2], B1[2][2];
    const char* cA = (const char*)g.A + (size_t)cur.pm * tstep; const char* cB = (const char*)g.Bt + (size_t)cur.pn * tstep;
    S.a_ready(cur);
    if constexpr (SP2) {
        PG8_STAGE(PG8_SB(0, 0), cB, voffB); PG8_STAGE(PG8_SB(0, 1), cB + hstep, voffB); PG8_STAGE(PG8_SA(0, 0), cA, voffA); PG8_STAGE(PG8_SA(0, 1), cA + hstep, voffA);
        if (wr == 1) PG8_BAR;
        PG8_WAIT_V(2); PG8_BAR;
        PG8_STAGE(PG8_SB(1, 0), cB + kstep, voffB); PG8_STAGE(PG8_SA(1, 0), cA + kstep, voffA); PG8_STAGE(PG8_SB(1, 1), cB + hstep + kstep, voffB);
        PG8_WAIT_V(6); PG8_BAR;
    } else {
        PG8_STAGE(PG8_SB(0, 0), cB, voffB); PG8_STAGE(PG8_SA(0, 0), cA, voffA); PG8_STAGE(PG8_SB(0, 1), cB + hstep, voffB); PG8_STAGE(PG8_SA(0, 1), cA + hstep, voffA);
        if (wr == 1) PG8_BAR;
        PG8_WAIT_V(4); PG8_BAR;
        PG8_STAGE(PG8_SB(1, 0), cB + kstep, voffB); PG8_STAGE(PG8_SA(1, 0), cA + kstep, voffA); PG8_STAGE(PG8_SB(1, 1), cB + hstep + kstep, voffB);
        PG8_WAIT_V(6); PG8_BAR;
    }
    for (;;) {
        const bool has_next = S.next(ui + 1, nxt);
        const char* nA = has_next ? (const char*)g.A + (size_t)nxt.pm * tstep : cA; const char* nB = has_next ? (const char*)g.Bt + (size_t)nxt.pn * tstep : cB;
        for (int t = 0; t < nt; t += 2) {
            const bool last = (t == nt - 2);
            const char* a1 = cA + (size_t)(t + 1) * kstep;
            const char* a2 = last ? nA : cA + (size_t)(t + 2) * kstep; const char* b2 = last ? nB : cB + (size_t)(t + 2) * kstep;
            const char* a3 = a2 + kstep; const char* b3 = b2 + kstep;
            if (last && has_next) S.a_ready(nxt);
            if constexpr (SP2) {
            PG8_LDB(B0, 0, 0); PG8_LDB(B1, 0, 1); PG8_SCHED; PG8_LDA(At, 0, 0); PG8_STAGE(PG8_SA(1, 1), a1 + hstep, voffA);
            PG8_WAIT_V(8); PG8_WAIT_L(0); PG8_BAR; PG8_MMA(0, 0, At, B0); PG8_MMA(0, 1, At, B1); PG8_BAR; PG8_SCHED;
            PG8_LDA(At, 0, 1); PG8_STAGE(PG8_SB(0, 0), b2, voffB); PG8_STAGE(PG8_SB(0, 1), b2 + hstep, voffB); PG8_STAGE(PG8_SA(0, 0), a2, voffA);
            PG8_WAIT_V(8); PG8_WAIT_L(0); PG8_BAR; PG8_MMA(1, 0, At, B0); PG8_MMA(1, 1, At, B1); PG8_BAR; PG8_SCHED;
            PG8_LDB(B0, 1, 0); PG8_LDB(B1, 1, 1); PG8_SCHED; PG8_LDA(At, 1, 0); PG8_STAGE(PG8_SA(0, 1), a2 + hstep, voffA);
            PG8_WAIT_V(8); PG8_WAIT_L(0); PG8_BAR; PG8_MMA(0, 0, At, B0); PG8_MMA(0, 1, At, B1); PG8_BAR; PG8_SCHED;
            PG8_LDA(At, 1, 1); PG8_STAGE(PG8_SB(1, 0), b3, voffB); PG8_STAGE(PG8_SB(1, 1), b3 + hstep, voffB); PG8_STAGE(PG8_SA(1, 0), a3, voffA);
            PG8_WAIT_V(8); PG8_WAIT_L(0); PG8_BAR; PG8_MMA(1, 0, At, B0); PG8_MMA(1, 1, At, B1); PG8_BAR; PG8_SCHED;
            } else {
            PG8_LDB(B0, 0, 0); PG8_SCHED; PG8_LDA(At, 0, 0); PG8_STAGE(PG8_SA(1, 1), a1 + hstep, voffA);
            PG8_WAIT_L(8); PG8_BAR; PG8_WAIT_L(0); PG8_MMA(0, 0, At, B0); PG8_BAR; PG8_SCHED;
            PG8_LDB(B1, 0, 1); PG8_STAGE(PG8_SB(0, 0), b2, voffB);
            PG8_BAR; PG8_WAIT_L(0); PG8_MMA(0, 1, At, B1); PG8_BAR;
            PG8_LDA(At, 0, 1); PG8_STAGE(PG8_SA(0, 0), a2, voffA);
            PG8_BAR; PG8_WAIT_L(0); PG8_MMA(1, 0, At, B0); PG8_BAR; PG8_SCHED;
            PG8_STAGE(PG8_SB(0, 1), b2 + hstep, voffB);
            PG8_WAIT_V(6); PG8_BAR; PG8_MMA(1, 1, At, B1); PG8_BAR;
            PG8_LDB(B0, 1, 0); PG8_SCHED; PG8_LDA(At, 1, 0); PG8_STAGE(PG8_SA(0, 1), a2 + hstep, voffA);
            PG8_WAIT_L(8); PG8_BAR; PG8_WAIT_L(0); PG8_MMA(0, 0, At, B0); PG8_BAR; PG8_SCHED;
            PG8_LDB(B1, 1, 1); PG8_STAGE(PG8_SB(1, 0), b3, voffB);
            PG8_BAR; PG8_WAIT_L(0); PG8_MMA(0, 1, At, B1); PG8_BAR;
            PG8_LDA(At, 1, 1); PG8_STAGE(PG8_SA(1, 0), a3, voffA);
            PG8_BAR; PG8_WAIT_L(0); PG8_MMA(1, 0, At, B0); PG8_BAR; PG8_SCHED;
            PG8_STAGE(PG8_SB(1, 1), b3 + hstep, voffB);
            PG8_WAIT_V(6); PG8_BAR; PG8_MMA(1, 1, At, B1); PG8_BAR;
            }
        }
        if constexpr (ALIGN_EPI) { if (wr == 0) PG8_BAR; }
        if constexpr (!Epi::AFTER_DRAIN) { E(acc, cur, wr, wc, fr, fq); S.done(cur); }
        if (!has_next) break;
#pragma unroll
        for (int a = 0; a < 2; ++a)
#pragma unroll
            for (int b = 0; b < 2; ++b)
#pragma unroll
                for (int m = 0; m < 4; ++m)
#pragma unroll
                    for (int n = 0; n < 2; ++n) acc[a][b][m][n] = (f32x4){0.f, 0.f, 0.f, 0.f};
        cur = nxt; cA = nA; cB = nB; ++ui;
        if constexpr (ALIGN_EPI) { if (wr == 1) PG8_BAR; }
    }
    PG8_WAIT_V(0);
    if constexpr (!ALIGN_EPI) { if (wr == 0) PG8_BAR; }
    PG8_BAR;
    if constexpr (Epi::AFTER_DRAIN) { E.fused(acc, cur, wr, wc, fr, fq, lds, wid, lane); S.done(cur); }
#undef PG8_SA
#undef PG8_SB
#undef PG8_STAGE
#undef PG8_LDA
#undef PG8_LDB
#undef PG8_MMA
#undef PG8_WAIT_V
#undef PG8_WAIT_L
#undef PG8_BAR
#undef PG8_SCHED
}
}
#define GAS __attribute__((address_space(1)))
#define LAS __attribute__((address_space(3)))
typedef unsigned short bf16;
typedef unsigned v4u __attribute__((ext_vector_type(4)));
typedef float f32x4 __attribute__((ext_vector_type(4)));
typedef short bf16x8 __attribute__((ext_vector_type(8)));
typedef GAS unsigned gu32;
typedef GAS unsigned long long gu64;
#define RLX_AGENT __ATOMIC_RELAXED, __HIP_MEMORY_SCOPE_AGENT
#define LDS_WAIT() asm volatile("s_waitcnt lgkmcnt(0)" ::: "memory")
#define VM_WAIT() asm volatile("s_waitcnt vmcnt(0)" ::: "memory")
__device__ __forceinline__ unsigned long long rt() { return __builtin_amdgcn_s_memrealtime(); }
__device__ __forceinline__ unsigned f2bf(float f) { unsigned u = __builtin_bit_cast(unsigned, f); return (u + 0x7fffu + ((u >> 16) & 1u)) >> 16; }
__device__ __forceinline__ unsigned pk2(float lo, float hi) { return f2bf(lo) | (f2bf(hi) << 16); }

#define XB_TMO      128
#define XB_XCNT(j)  (256  + 64 * (j))
#define XB_XSUB(j)  (1280 + 64 * (j))
#define XB_XGEN(j)  (2304 + 64 * (j))
#define XB_TOP      3328
#define XB_TOPGEN   3392
#define XCD_BAR_WORDS 3456
#define XB_SPIN_CAP (1u << 18)

__device__ __forceinline__ unsigned xb_ld(unsigned* p)              { return __hip_atomic_load(p, __ATOMIC_RELAXED, __HIP_MEMORY_SCOPE_AGENT); }
__device__ __forceinline__ unsigned xb_add(unsigned* p, unsigned v) { return __hip_atomic_fetch_add(p, v, __ATOMIC_RELAXED, __HIP_MEMORY_SCOPE_AGENT); }
__device__ __forceinline__ unsigned xb_xcc_id() { return (unsigned)__builtin_amdgcn_s_getreg((3 << 11) | 20) & 0xFu; }
#define XB_SPIN(cond, bar) do { unsigned _sp = 0; while (cond) { __builtin_amdgcn_s_sleep(1); \
    if ((++_sp & 255u) == 0u) { if (xb_ld(&(bar)[XB_TMO])) break; if (_sp > XB_SPIN_CAP) { atomicAdd(&(bar)[XB_TMO], 1u); break; } } } } while (0)

struct XcdBarrier {
    unsigned* bar; unsigned x;
    volatile LAS unsigned* st;
};

__device__ __forceinline__ XcdBarrier xcd_barrier_post(unsigned* bar, volatile LAS unsigned* st) {
    XcdBarrier b; b.bar = bar; b.x = xb_xcc_id(); b.st = st;
    if (threadIdx.x == 0) (void)xb_add(&bar[XB_XCNT(b.x)], 1u);
    return b;
}
__device__ __forceinline__ void xcd_barrier_complete(unsigned* bar, unsigned x, unsigned& nloc, unsigned& nx) {
    const unsigned G = gridDim.x * gridDim.y * gridDim.z;
    unsigned sum, cnt, mine, sp = 0u;
    for (;;) {
        sum = 0u; cnt = 0u; mine = 0u;
#pragma unroll
        for (unsigned j = 0; j < 16; ++j) { const unsigned c = xb_ld(&bar[XB_XCNT(j)]); sum += c; cnt += (c > 0u) ? 1u : 0u; mine = (j == x) ? c : mine; }
        if (sum == G) break;
        __builtin_amdgcn_s_sleep(1);
        if ((++sp & 255u) == 0u) { if (xb_ld(&bar[XB_TMO])) break; if (sp > XB_SPIN_CAP) { atomicAdd(&bar[XB_TMO], 1u); break; } }
    }
    nloc = mine > 0u ? mine : 1u; nx = cnt > 0u ? cnt : 1u;
}

__device__ __forceinline__ void xcd_barrier(const XcdBarrier& b) {
    asm volatile("s_waitcnt vmcnt(0)" ::: "memory");
    __syncthreads();
    if (threadIdx.x == 0) {
        unsigned* bar = b.bar;
        __builtin_amdgcn_s_waitcnt(0);
        unsigned nloc = b.st[0], nx = b.st[1];
        if (nloc == 0u) { xcd_barrier_complete(bar, b.x, nloc, nx); b.st[0] = nloc; b.st[1] = nx; }
        const unsigned old = xb_add(&bar[XB_XSUB(b.x)], 1u);
        const unsigned gen = old / nloc;
        if (old + 1u == (gen + 1u) * nloc) {
            __builtin_amdgcn_fence(__ATOMIC_RELEASE, "agent");
            asm volatile("s_waitcnt vmcnt(0)" ::: "memory");
            const unsigned og = xb_add(&bar[XB_TOP], 1u);
            const unsigned tg = og / nx;
            if (og + 1u == (tg + 1u) * nx) xb_add(&bar[XB_TOPGEN], 1u);
            else XB_SPIN(xb_ld(&bar[XB_TOPGEN]) == tg, bar);
            __builtin_amdgcn_fence(__ATOMIC_ACQUIRE, "agent");
            xb_add(&bar[XB_XGEN(b.x)], 1u);
            asm volatile("s_waitcnt vmcnt(0)" ::: "memory");
        } else {
            XB_SPIN(xb_ld(&bar[XB_XGEN(b.x)]) == gen, bar);
            __builtin_amdgcn_fence(__ATOMIC_ACQUIRE, "agent");
            asm volatile("s_waitcnt vmcnt(0)" ::: "memory");
        }
    }
    __syncthreads();
}
constexpr int NWAVES = 8;
constexpr int DM = 1024, NCTX = 8192, NLAT = 4096, MTOK = NCTX + NLAT, DIN = 4096, DFF = 2816, NUP = 2 * DFF, NMOD = 6 * DM;
constexpr int ZP = 4096;
constexpr float EPS = 1e-6f;
constexpr int NPH = 11;
constexpr size_t MiB = 1u << 20;
constexpr size_t WS_CTL = 0, CTL_ZERO_BYTES = 1 * MiB;
constexpr size_t WS_MOD = 512 * 1024;
constexpr size_t WS_WIN = 1 * MiB, WS_WP = 9 * MiB, WS_WN = 10 * MiB, WS_WO = 11 * MiB, WS_WUP = 13 * MiB, WS_WD = 24 * MiB, WS_WPOOL = 30 * MiB;
constexpr size_t WS_CK = 30 * MiB + 512 * 1024, WS_CV = 31 * MiB + 512 * 1024;
constexpr size_t WS_XN = 33 * MiB;
constexpr size_t WS_Z = 57 * MiB;
constexpr size_t WS_U = 57 * MiB;
constexpr size_t WS_NA = 189 * MiB, WS_MIX = 201 * MiB, WS_MB = 213 * MiB;
constexpr size_t WS_ACT = 189 * MiB;
constexpr size_t WS_END = 256 * MiB;
static_assert(WS_U + (size_t)MTOK * NUP * 2 <= WS_NA && WS_ACT + (size_t)MTOK * DFF * 2 <= WS_END && WS_MB + (size_t)MTOK * DM * 2 <= WS_END, "ws map");
constexpr int CW_BAR = 4096;
constexpr int RING_OFF = 0, RING_BYTES = 131072;
constexpr int LDSCTL_OFF = RING_BYTES, MISC_OFF = LDSCTL_OFF + 320;
constexpr int LDS_BYTES = 147456;

#define LAS __attribute__((address_space(3)))
typedef unsigned short bf16;
typedef unsigned v4u __attribute__((ext_vector_type(4)));
typedef unsigned v2u __attribute__((ext_vector_type(2)));
typedef float f32x4 __attribute__((ext_vector_type(4)));
typedef float f32x16 __attribute__((ext_vector_type(16)));
typedef short bf16x8 __attribute__((ext_vector_type(8)));
typedef short s16x4 __attribute__((ext_vector_type(4)));
#define LDS_WAIT() asm volatile("s_waitcnt lgkmcnt(0)" ::: "memory")
using pg8::cvt_pk_bf16; using pg8::bf_lo; using pg8::bf_hi;

struct Args { const float* in[23]; float* out; unsigned char* ws; int ph_lo, ph_hi; };

__device__ __forceinline__ float wave_sum(float v) {
#pragma unroll
    for (int o = 1; o < 64; o <<= 1) v += __shfl_xor(v, o);
    return v;
}
__device__ __forceinline__ float siluf_(float x) { return x * __builtin_amdgcn_rcpf(1.0f + __builtin_amdgcn_exp2f(-1.4426950408889634f * x)); }

__device__ __forceinline__ void p0_transpose_item(const float* W, int K, int N, bf16* WT, int k0, int n0, int drow0, LAS float* scr, int lane) {
#pragma unroll 8
    for (int i = 0; i < 32; ++i) { const int kk = 2 * i + (lane >> 5); scr[kk * 33 + (lane & 31)] = W[(size_t)(k0 + kk) * N + n0 + (lane & 31)]; }
    LDS_WAIT(); asm volatile("" ::: "memory");
    const int c = lane & 7;
#pragma unroll
    for (int j = 0; j < 4; ++j) { const int n = (lane >> 3) + 8 * j; const LAS float* s = scr + (8 * c) * 33 + n;
        v4u o; o.x = cvt_pk_bf16(s[0 * 33], s[1 * 33]); o.y = cvt_pk_bf16(s[2 * 33], s[3 * 33]); o.z = cvt_pk_bf16(s[4 * 33], s[5 * 33]); o.w = cvt_pk_bf16(s[6 * 33], s[7 * 33]);
        *(v4u*)(WT + (size_t)(drow0 + n) * K + k0 + 8 * c) = o; }
    LDS_WAIT(); asm volatile("" ::: "memory");
}

__device__ __forceinline__ void phase_prologue(const Args& a, LAS unsigned char* lds, int gw, int NGW, int wave, int lane) {
    unsigned char* ws = a.ws;
    LAS float* scr = (LAS float*)(lds + RING_OFF + wave * 16384);
    float* MOD = (float*)(ws + WS_MOD);
    for (int t = gw; t < 96 * 16; t += NGW) {
        const int cg = t % 96, ks = t / 96, col = cg * 64 + lane, k0 = ks * 64;
        const float s0 = siluf_(a.in[5][k0 + lane]), s1 = siluf_(a.in[4][k0 + lane]), s2 = siluf_(a.in[4][1024 + k0 + lane]);
        float a0 = 0.f, a1 = 0.f, a2 = 0.f;
        const float* wp = a.in[8] + (size_t)k0 * NMOD + col;
#pragma unroll 16
        for (int kk = 0; kk < 64; ++kk) { const float w = wp[(size_t)kk * NMOD];
            a0 += __shfl(s0, kk) * w; a1 += __shfl(s1, kk) * w; a2 += __shfl(s2, kk) * w; }
        if (ks == 0) { const float b = a.in[9][col]; a0 += b; a1 += b; a2 += b; }
        atomicAdd(MOD + col, a0); atomicAdd(MOD + NMOD + col, a1); atomicAdd(MOD + 2 * NMOD + col, a2);
    }
    constexpr int I_IN = 16 * 128, I_P = 8 * 32, I_O = 16 * 32, I_UP = 16 * 176, I_D = 44 * 32, I_PW = 4 * 8;
    constexpr int NITEMS = I_IN + 2 * I_P + I_O + I_UP + I_D + I_PW;
    for (int it = gw; it < NITEMS; it += NGW) {
        int r = it;
        if (r < I_IN) { const int kb = r / 128, nb = r % 128; p0_transpose_item(a.in[10], 1024, 4096, (bf16*)(ws + WS_WIN), kb * 64, nb * 32, nb * 32, scr, lane); continue; } r -= I_IN;
        if (r < I_P) { const int kb = r / 32, nb = r % 32; p0_transpose_item(a.in[16], 512, 1024, (bf16*)(ws + WS_WP), kb * 64, nb * 32, nb * 32, scr, lane); continue; } r -= I_P;
        if (r < I_P) { const int kb = r / 32, nb = r % 32; p0_transpose_item(a.in[17], 512, 1024, (bf16*)(ws + WS_WN), kb * 64, nb * 32, nb * 32, scr, lane); continue; } r -= I_P;
        if (r < I_O) { const int kb = r / 32, nb = r % 32; p0_transpose_item(a.in[18], 1024, 1024, (bf16*)(ws + WS_WO), kb * 64, nb * 32, nb * 32, scr, lane); continue; } r -= I_O;
        if (r < I_UP) { const int kb = r / 176, nb = r % 176, n0 = nb * 32;
            const int drow = n0 < DFF ? 256 * (n0 / 128) + (n0 % 128) : 256 * ((n0 - DFF) / 128) + 128 + ((n0 - DFF) % 128);
            p0_transpose_item(a.in[19], 1024, NUP, (bf16*)(ws + WS_WUP), kb * 64, n0, drow, scr, lane); continue; } r -= I_UP;
        if (r < I_D) { const int kb = r / 32, nb = r % 32; p0_transpose_item(a.in[22], DFF, 1024, (bf16*)(ws + WS_WD), kb * 64, nb * 32, nb * 32, scr, lane); continue; } r -= I_D;
        { const int g = r / 8, q = r % 8, kb = q / 4, nb = q % 4; p0_transpose_item(a.in[13] + (size_t)g * 128 * 128, 128, 128, (bf16*)(ws + WS_WPOOL) + (size_t)g * 128 * 128, kb * 64, nb * 32, nb * 32, scr, lane); }
    }
    for (int i = gw * 64 + lane; i < 2 * 65536; i += NGW * 64) {
        const int t = i >> 16, e = (i & 65535) * 8; const float* src = a.in[2 + t] + e;
        const f32x4 x0 = *(const f32x4*)src, x1 = *(const f32x4*)(src + 4);
        v4u o; o.x = cvt_pk_bf16(x0[0], x0[1]); o.y = cvt_pk_bf16(x0[2], x0[3]); o.z = cvt_pk_bf16(x1[0], x1[1]); o.w = cvt_pk_bf16(x1[2], x1[3]);
        *(v4u*)((bf16*)(ws + (t ? WS_CV : WS_CK)) + e) = o;
    }
}

__device__ __forceinline__ void modnorm_row(const float* xrow, bf16* orow, const float* g, const float* modv, int sh, int lane) {
    f32x4 v[4]; float s = 0.f;
#pragma unroll
    for (int j = 0; j < 4; ++j) { v[j] = *(const f32x4*)(xrow + 256 * j + 4 * lane); s += (v[j][0] * v[j][0] + v[j][1] * v[j][1]) + (v[j][2] * v[j][2] + v[j][3] * v[j][3]); }
    const float rstd = 1.0f / sqrtf(wave_sum(s) * (1.f / DM) + EPS);
#pragma unroll
    for (int j = 0; j < 4; ++j) { const int c = 256 * j + 4 * lane;
        const f32x4 gg = *(const f32x4*)(g + c), shf = *(const f32x4*)(modv + sh * 1024 + c), scl = *(const f32x4*)(modv + (sh + 1) * 1024 + c);
        const f32x4 y = v[j] * rstd * gg * (scl + 1.0f) + shf;
        v2u o; o.x = cvt_pk_bf16(y[0], y[1]); o.y = cvt_pk_bf16(y[2], y[3]);
        *(v2u*)(orow + c) = o; }
}
__device__ __forceinline__ int mod_of_row(int m) { return m < NCTX ? 0 : 1 + ((m - NCTX) >> 11); }

__device__ __forceinline__ void e1_row(const Args& a, bf16* zrow, int m, int lane) {
    const v4u q = *(const v4u*)(zrow + 512 + 8 * lane), k = *(const v4u*)(zrow + 1024 + 8 * lane), v = *(const v4u*)(zrow + 1536 + 8 * lane);
    float qf[8] = {bf_lo(q.x), bf_hi(q.x), bf_lo(q.y), bf_hi(q.y), bf_lo(q.z), bf_hi(q.z), bf_lo(q.w), bf_hi(q.w)};
    float kf[8] = {bf_lo(k.x), bf_hi(k.x), bf_lo(k.y), bf_hi(k.y), bf_lo(k.z), bf_hi(k.z), bf_lo(k.w), bf_hi(k.w)};
    float sq = 0.f, sk = 0.f;
#pragma unroll
    for (int e = 0; e < 8; ++e) { sq += qf[e] * qf[e]; sk += kf[e] * kf[e]; }
    sq += __shfl_xor(sq, 1); sq += __shfl_xor(sq, 2); sq += __shfl_xor(sq, 4);
    sk += __shfl_xor(sk, 1); sk += __shfl_xor(sk, 2); sk += __shfl_xor(sk, 4);
    const float rq = 1.0f / sqrtf(sq * (1.f / 64) + EPS), rk = 1.0f / sqrtf(sk * (1.f / 64) + EPS);
    const int d0 = (lane & 7) * 8;
    const f32x4 qg0 = *(const f32x4*)(a.in[11] + d0), qg1 = *(const f32x4*)(a.in[11] + d0 + 4), kg0 = *(const f32x4*)(a.in[12] + d0), kg1 = *(const f32x4*)(a.in[12] + d0 + 4);
#pragma unroll
    for (int e = 0; e < 4; ++e) { qf[e] *= rq * qg0[e]; qf[4 + e] *= rq * qg1[e]; kf[e] *= rk * kg0[e]; kf[4 + e] *= rk * kg1[e]; }
    v4u o; o.x = cvt_pk_bf16(qf[0], qf[1]); o.y = cvt_pk_bf16(qf[2], qf[3]); o.z = cvt_pk_bf16(qf[4], qf[5]); o.w = cvt_pk_bf16(qf[6], qf[7]);
    *(v4u*)(zrow + 512 + 8 * lane) = o;
    o.x = cvt_pk_bf16(kf[0], kf[1]); o.y = cvt_pk_bf16(kf[2], kf[3]); o.z = cvt_pk_bf16(kf[4], kf[5]); o.w = cvt_pk_bf16(kf[6], kf[7]);
    *(v4u*)(zrow + 1024 + 8 * lane) = o;
    if (m < NCTX) {
        const int b = m >> 8, t = m & 255, h = lane >> 3;
        const size_t off = ((size_t)(b * 8 + h) * 256 + t) * 64 + d0;
        float* nk = a.out + (size_t)MTOK * DM + off; float* nv = a.out + (size_t)MTOK * DM + (size_t)NCTX * 512 + off;
        *(f32x4*)nk = (f32x4){kf[0], kf[1], kf[2], kf[3]}; *(f32x4*)(nk + 4) = (f32x4){kf[4], kf[5], kf[6], kf[7]};
        *(f32x4*)nv = (f32x4){bf_lo(v.x), bf_hi(v.x), bf_lo(v.y), bf_hi(v.y)}; *(f32x4*)(nv + 4) = (f32x4){bf_lo(v.z), bf_hi(v.z), bf_lo(v.w), bf_hi(v.w)};
    }
}

typedef short v4i16_t __attribute__((ext_vector_type(4)));
__device__ __forceinline__ s16x4 vtr(const LAS unsigned char* p) { return __builtin_bit_cast(s16x4, __builtin_amdgcn_ds_read_tr16_b64_v4i16((LAS v4i16_t*)p)); }
constexpr int VS = 144;
constexpr float NEGBIG = -1e30f;
__device__ __forceinline__ int clampi(int x, int lo, int hi) { return x < lo ? lo : (x > hi ? hi : x); }

__device__ __forceinline__ void attn_task(const Args& a, LAS unsigned char* vl, bool latent, int id, int lane) {
    const bf16* Z = (const bf16*)(a.ws + WS_Z);
    const bf16* CK = (const bf16*)(a.ws + WS_CK); const bf16* CV = (const bf16*)(a.ws + WS_CV);
    bf16* NA = (bf16*)(a.ws + WS_NA);
    const int r32 = lane & 31, hi = lane >> 5;
    int b, h, qtok, nblk, qrow = 0, qcol = 0, rlo = 0, bs = 0;
    if (!latent) { const int qb = id & 7; h = (id >> 3) & 7; b = id >> 6; qtok = b * 256 + qb * 32 + r32; nblk = 8; }
    else { const int nq = id & 3, rp = (id >> 2) & 15; h = (id >> 6) & 7; b = id >> 9; qrow = 2 * rp + (r32 >> 4); qcol = 16 * nq + (r32 & 15); qtok = NCTX + b * 2048 + qrow * 64 + qcol;
        rlo = clampi(2 * rp - 4, 0, 24); const int rhi = clampi(2 * rp - 3, 0, 24) + 7; bs = clampi(16 * nq - 8, 0, 32); nblk = 16 + (rhi - rlo + 1); }
    const int rs_q = clampi(qrow - 4, 0, 24), ws_q = clampi(qcol - 8, 0, 48);
    const float* rpb = a.in[15] + h * (15 * 31);
    bf16x8 qf[4];
#pragma unroll
    for (int s = 0; s < 4; ++s) qf[s] = *(const bf16x8*)(Z + (size_t)qtok * ZP + 512 + h * 64 + 16 * s + 8 * hi);
    constexpr float SC = 0.125f * 1.4426950408889634f, L2E = 1.4426950408889634f;
    float mrun = NEGBIG, lrun = 0.f;
    f32x16 o0 = {}, o1 = {};
    bf16x8 kn[4]; v4u vn[4];
#define ATT_LOAD(t) do { const bf16* kp_; const bf16* vp_; int pitch_; \
        if (latent && (t) < 16) { const size_t o_ = ((size_t)(b * 8 + h) * 512 + 32 * (t)) * 64; kp_ = CK + o_; vp_ = CV + o_; pitch_ = 64; } \
        else { const int tok_ = latent ? NCTX + b * 2048 + (rlo + (t) - 16) * 64 + bs : b * 256 + 32 * (t); kp_ = Z + (size_t)tok_ * ZP + 1024 + h * 64; vp_ = kp_ + 512; pitch_ = ZP; } \
        _Pragma("unroll") for (int s = 0; s < 4; ++s) kn[s] = *(const bf16x8*)(kp_ + (size_t)r32 * pitch_ + 16 * s + 8 * hi); \
        _Pragma("unroll") for (int i = 0; i < 4; ++i) { const int c_ = i * 64 + lane; vn[i] = *(const v4u*)(vp_ + (size_t)(c_ >> 3) * pitch_ + (c_ & 7) * 8); } } while (0)
    ATT_LOAD(0);
    const int li = lane & 15;
    const LAS unsigned char* vrd = vl + (4 * hi + (li >> 2)) * VS + (16 * ((lane >> 4) & 1) + 4 * (li & 3)) * 2;
    for (int t = 0; t < nblk; ++t) {
        bf16x8 kf[4]; v4u vr[4];
#pragma unroll
        for (int s = 0; s < 4; ++s) { kf[s] = kn[s]; vr[s] = vn[s]; }
        if (t + 1 < nblk) ATT_LOAD(t + 1);
        asm volatile("" ::: "memory");
#pragma unroll
        for (int i = 0; i < 4; ++i) { const int c_ = i * 64 + lane; *(LAS v4u*)(vl + (c_ >> 3) * VS + (c_ & 7) * 16) = vr[i]; }
        asm volatile("" ::: "memory");
        f32x16 s = {};
#pragma unroll
        for (int k = 0; k < 4; ++k) s = __builtin_amdgcn_mfma_f32_32x32x16_bf16(kf[k], qf[k], s, 0, 0, 0);
        const bool loc = latent && t >= 16;
        const int kr = rlo + t - 16;
        float x[16]; float bm = NEGBIG;
#pragma unroll
        for (int i = 0; i < 16; ++i) {
            float v = s[i] * SC;
            if (loc) { const int kc = bs + (i & 3) + 8 * (i >> 2) + 4 * hi;
                const bool ok = (kr >= rs_q) && (kr < rs_q + 8) && (kc >= ws_q) && (kc < ws_q + 16);
                const int bi = ok ? (kr - qrow + 7) * 31 + (kc - qcol + 15) : 0;
                const float bias = rpb[bi];
                v = ok ? v + bias * L2E : NEGBIG; }
            x[i] = v; bm = fmaxf(bm, v); }
        bm = fmaxf(bm, __shfl_xor(bm, 32));
        const float mn = fmaxf(mrun, bm), alpha = __builtin_amdgcn_exp2f(mrun - mn); mrun = mn;
        float ps = 0.f;
#pragma unroll
        for (int i = 0; i < 16; ++i) { x[i] = __builtin_amdgcn_exp2f(x[i] - mn); ps += x[i]; }
        lrun = lrun * alpha + ps;
#pragma unroll
        for (int i = 0; i < 16; ++i) { o0[i] *= alpha; o1[i] *= alpha; }
        bf16x8 pf[2];
#pragma unroll
        for (int sp = 0; sp < 2; ++sp) { v4u w; w.x = cvt_pk_bf16(x[8 * sp + 0], x[8 * sp + 1]); w.y = cvt_pk_bf16(x[8 * sp + 2], x[8 * sp + 3]); w.z = cvt_pk_bf16(x[8 * sp + 4], x[8 * sp + 5]); w.w = cvt_pk_bf16(x[8 * sp + 6], x[8 * sp + 7]); pf[sp] = __builtin_bit_cast(bf16x8, w); }
#pragma unroll
        for (int sp = 0; sp < 2; ++sp) {
            const s16x4 l0 = vtr(vrd + (16 * sp) * VS), h0 = vtr(vrd + (16 * sp + 8) * VS), l1 = vtr(vrd + (16 * sp) * VS + 64), h1 = vtr(vrd + (16 * sp + 8) * VS + 64);
            const bf16x8 v0 = (bf16x8){l0[0], l0[1], l0[2], l0[3], h0[0], h0[1], h0[2], h0[3]}, v1 = (bf16x8){l1[0], l1[1], l1[2], l1[3], h1[0], h1[1], h1[2], h1[3]};
            o0 = __builtin_amdgcn_mfma_f32_32x32x16_bf16(v0, pf[sp], o0, 0, 0, 0);
            o1 = __builtin_amdgcn_mfma_f32_32x32x16_bf16(v1, pf[sp], o1, 0, 0, 0);
        }
        asm volatile("" ::: "memory");
    }
#undef ATT_LOAD
    const float inv = 1.0f / (lrun + __shfl_xor(lrun, 32));
    const int otok = latent ? qtok : (qtok & ~255) + 2 * (qtok & 127) + ((qtok >> 7) & 1);
    bf16* op = NA + (size_t)otok * 512 + h * 64 + 4 * hi;
#pragma unroll
    for (int g = 0; g < 4; ++g) {
        v2u w0; w0.x = cvt_pk_bf16(o0[4 * g] * inv, o0[4 * g + 1] * inv); w0.y = cvt_pk_bf16(o0[4 * g + 2] * inv, o0[4 * g + 3] * inv);
        v2u w1; w1.x = cvt_pk_bf16(o1[4 * g] * inv, o1[4 * g + 1] * inv); w1.y = cvt_pk_bf16(o1[4 * g + 2] * inv, o1[4 * g + 3] * inv);
        *(v2u*)(op + 8 * g) = w0; *(v2u*)(op + 32 + 8 * g) = w1;
    }
}

__device__ __forceinline__ void pool_task(const Args& a, int pt, int lane) {
    const bf16* Z = (const bf16*)(a.ws + WS_Z); const bf16* WPL = (const bf16*)(a.ws + WS_WPOOL); bf16* MIX = (bf16*)(a.ws + WS_MIX);
    typedef float f32x4v __attribute__((ext_vector_type(4)));
    const int g = pt & 3, ti = pt >> 2, tok0 = ti * 16, fr = lane & 15, kq = lane >> 4;
    const int L = tok0 < NCTX ? 256 : 2048, s0 = tok0 < NCTX ? (tok0 & ~255) : NCTX + ((tok0 - NCTX) & ~2047);
    const int tok = tok0 + fr, tpos = tok - s0, half = 1 << g;
    const int lo = tpos - half < 0 ? 0 : tpos - half, hi = tpos + half > L ? L : tpos + half;
    const float rc = 1.0f / (float)(hi - lo);
    bf16x8 pfrag[4];
#pragma unroll
    for (int s = 0; s < 4; ++s) {
        const bf16* colp = Z + g * 128 + 32 * s + 8 * kq;
        float sum[8];
#pragma unroll
        for (int e = 0; e < 8; ++e) sum[e] = 0.f;
        for (int off = -half; off < half; ++off) { const int tp = tpos + off;
            if (tp >= 0 && tp < L) { const v4u w = *(const v4u*)(colp + (size_t)(s0 + tp) * ZP);
                sum[0] += bf_lo(w.x); sum[1] += bf_hi(w.x); sum[2] += bf_lo(w.y); sum[3] += bf_hi(w.y); sum[4] += bf_lo(w.z); sum[5] += bf_hi(w.z); sum[6] += bf_lo(w.w); sum[7] += bf_hi(w.w); } }
        const v4u c = *(const v4u*)(colp + (size_t)tok * ZP);
        v4u w; w.x = cvt_pk_bf16(sum[0] * rc - bf_lo(c.x), sum[1] * rc - bf_hi(c.x)); w.y = cvt_pk_bf16(sum[2] * rc - bf_lo(c.y), sum[3] * rc - bf_hi(c.y));
        w.z = cvt_pk_bf16(sum[4] * rc - bf_lo(c.z), sum[5] * rc - bf_hi(c.z)); w.w = cvt_pk_bf16(sum[6] * rc - bf_lo(c.w), sum[7] * rc - bf_hi(c.w));
        pfrag[s] = __builtin_bit_cast(bf16x8, w);
    }
    const bf16* wg = WPL + (size_t)g * 128 * 128;
#pragma unroll
    for (int nb = 0; nb < 8; ++nb) {
        f32x4v acc = {0.f, 0.f, 0.f, 0.f};
#pragma unroll
        for (int s = 0; s < 4; ++s) { const bf16x8 wf = *(const bf16x8*)(wg + (size_t)(16 * nb + fr) * 128 + 32 * s + 8 * kq);
            acc = __builtin_amdgcn_mfma_f32_16x16x32_bf16(wf, pfrag[s], acc, 0, 0, 0); }
        const int d = g * 128 + 16 * nb + 4 * kq;
        const f32x4v sp = *(const f32x4v*)(a.in[14] + d);
        v2u w; w.x = cvt_pk_bf16(acc[0] * sp[0], acc[1] * sp[1]); w.y = cvt_pk_bf16(acc[2] * sp[2], acc[3] * sp[3]);
        *(v2u*)(MIX + (size_t)tok * 512 + d) = w;
    }
}

__device__ __forceinline__ void e3_row(const Args& a, int m, int lane) {
    const bf16* U = (const bf16*)(a.ws + WS_U); bf16* ACT = (bf16*)(a.ws + WS_ACT);
    const int L = m < NCTX ? 256 : 2048, tpos = m < NCTX ? (m & 255) : ((m - NCTX) & 2047);
    const bool hp = tpos > 0, hn = tpos < L - 1;
    const float* cw = a.in[20]; const float* cb = a.in[21];
    for (int ch = lane; ch < 352; ch += 64) {
        const int pn = ch >> 4, cc = (ch & 15) * 8, pa = 256 * pn + cc, na = 128 * pn + cc;
        const bf16* up = U + (size_t)m * NUP + pa;
        const v4u z4 = {0u, 0u, 0u, 0u};
        const v4u a0 = hp ? *(const v4u*)(up - NUP) : z4, a1 = *(const v4u*)up, a2 = hn ? *(const v4u*)(up + NUP) : z4;
        const v4u g0 = hp ? *(const v4u*)(up - NUP + 128) : z4, g1 = *(const v4u*)(up + 128), g2 = hn ? *(const v4u*)(up + NUP + 128) : z4;
        float av[8], gv[8];
        const unsigned aw0[4] = {a0.x, a0.y, a0.z, a0.w}, aw1[4] = {a1.x, a1.y, a1.z, a1.w}, aw2[4] = {a2.x, a2.y, a2.z, a2.w};
        const unsigned gw0[4] = {g0.x, g0.y, g0.z, g0.w}, gw1[4] = {g1.x, g1.y, g1.z, g1.w}, gw2[4] = {g2.x, g2.y, g2.z, g2.w};
#pragma unroll
        for (int e = 0; e < 8; ++e) { const int q = e >> 1; const bool h_ = e & 1;
            const float ua0 = h_ ? bf_hi(aw0[q]) : bf_lo(aw0[q]), ua1 = h_ ? bf_hi(aw1[q]) : bf_lo(aw1[q]), ua2 = h_ ? bf_hi(aw2[q]) : bf_lo(aw2[q]);
            const float ug0 = h_ ? bf_hi(gw0[q]) : bf_lo(gw0[q]), ug1 = h_ ? bf_hi(gw1[q]) : bf_lo(gw1[q]), ug2 = h_ ? bf_hi(gw2[q]) : bf_lo(gw2[q]);
            const int ia = na + e, ig = DFF + na + e;
            av[e] = cw[ia] * ua0 + cw[NUP + ia] * ua1 + cw[2 * NUP + ia] * ua2 + cb[ia];
            gv[e] = cw[ig] * ug0 + cw[NUP + ig] * ug1 + cw[2 * NUP + ig] * ug2 + cb[ig];
            av[e] = siluf_(av[e]) * gv[e]; }
        v4u o; o.x = cvt_pk_bf16(av[0], av[1]); o.y = cvt_pk_bf16(av[2], av[3]); o.z = cvt_pk_bf16(av[4], av[5]); o.w = cvt_pk_bf16(av[6], av[7]);
        *(v4u*)(ACT + (size_t)m * DFF + na) = o;
    }
}

__global__ void __launch_bounds__(NWAVES * 64, 2) fwd_kernel(Args args) {
    extern __shared__ __attribute__((aligned(16))) unsigned char lds_raw[];
    LAS unsigned char* lds = (LAS unsigned char*)lds_raw;
    volatile LAS unsigned* MISC = (volatile LAS unsigned*)(lds + MISC_OFF);
    const int tid = threadIdx.x, lane = tid & 63, wave = __builtin_amdgcn_readfirstlane(tid >> 6);
    const int G = gridDim.x, bx = blockIdx.x, vcu = (G % 8 == 0) ? (bx % 8) * (G / 8) + bx / 8 : bx;
    const int gw = vcu * NWAVES + wave, NGW = G * NWAVES;
    unsigned char* ws = args.ws;
    for (int u = tid; u < (LDS_BYTES - LDSCTL_OFF) / 4; u += NWAVES * 64) ((LAS unsigned*)(lds + LDSCTL_OFF))[u] = 0u;
    __syncthreads();
#if MK_PER_PHASE
#define GRID_BAR() do { } while (0)
#else
    XcdBarrier bar = xcd_barrier_post((unsigned*)(ws + WS_CTL) + CW_BAR, MISC + 8);
#define GRID_BAR() xcd_barrier(bar)
#endif
    const int lo = args.ph_lo, hi = args.ph_hi;
#define IN(k) (lo <= (k) && (k) < hi)
#define SEAM(k) do { if (IN(k) && IN((k) + 1)) GRID_BAR(); } while (0)
    const float* MOD = (const float*)(ws + WS_MOD);
    bf16* XN = (bf16*)(ws + WS_XN); bf16* Zb = (bf16*)(ws + WS_Z);
    float* Y = args.out;

    if (IN(0)) { phase_prologue(args, lds, gw, NGW, wave, lane); } SEAM(0);
    if (IN(1)) { for (int m = gw; m < MTOK; m += NGW) { const float* xr = m < NCTX ? args.in[0] + (size_t)m * DM : args.in[1] + (size_t)(m - NCTX) * DM;
            modnorm_row(xr, XN + (size_t)m * DM, args.in[6], MOD + mod_of_row(m) * NMOD, 0, lane); } } SEAM(1);
    if (IN(2)) { pg8::Gemm g{XN, (const bf16*)(ws + WS_WIN), MTOK, DIN, DM}; pg8::StaticOrder S; S.init(MTOK, DIN, G, bx);
        pg8::EpiStoreBf16 E{Zb, ZP}; pg8::gemm_phase<pg8::EpiStoreBf16, pg8::StaticOrder, true, true>(lds + RING_OFF, g, S, E); } SEAM(2);
    if (IN(3)) { for (int m = gw; m < MTOK; m += NGW) e1_row(args, Zb + (size_t)m * ZP, m, lane); } SEAM(3);
    if (IN(4)) {
        LAS unsigned char* vl = lds + RING_OFF + wave * 8192;
        if (wave < 4) { for (int id = vcu * 4 + wave; id < 1024; id += G * 4) attn_task(args, vl, true, id, lane); }
        else { for (int id = vcu * 4 + (wave - 4); id < 1024; id += G * 4) { attn_task(args, vl, false, 2 * id, lane); attn_task(args, vl, false, 2 * id + 1, lane); } }
        for (int pt = gw; pt < (MTOK / 16) * 4; pt += NGW) pool_task(args, pt, lane);
    } SEAM(4);
    if (IN(5)) { bf16* T1 = XN;
        { pg8::Gemm g{(const bf16*)(ws + WS_MIX), (const bf16*)(ws + WS_WP), MTOK, DM, 512}; pg8::StaticOrder S; S.init(MTOK, DM, G, bx);
          pg8::EpiStoreBf16 E{T1, DM}; pg8::gemm_phase<pg8::EpiStoreBf16, pg8::StaticOrder, true, true>(lds + RING_OFF, g, S, E); }
        asm volatile("s_waitcnt vmcnt(0)" ::: "memory"); __syncthreads();
        { pg8::Gemm g{(const bf16*)(ws + WS_NA), (const bf16*)(ws + WS_WN), MTOK, DM, 512}; pg8::StaticOrder S; S.init(MTOK, DM, G, bx);
          pg8::EpiMerge E{T1, Zb, (bf16*)(ws + WS_MB)}; pg8::gemm_phase<pg8::EpiMerge, pg8::StaticOrder, true, true>(lds + RING_OFF, g, S, E); }
    } SEAM(5);
    if (IN(6)) { pg8::Gemm g{(const bf16*)(ws + WS_MB), (const bf16*)(ws + WS_WO), MTOK, DM, DM}; pg8::StaticOrder S; S.init(MTOK, DM, G, bx);
        pg8::EpiResid E{args.in[0], args.in[1], Y, MOD + 2 * DM}; pg8::gemm_phase<pg8::EpiResid, pg8::StaticOrder, true, true>(lds + RING_OFF, g, S, E); } SEAM(6);
    if (IN(7)) { for (int m = gw; m < MTOK; m += NGW) modnorm_row(Y + (size_t)m * DM, XN + (size_t)m * DM, args.in[7], MOD + mod_of_row(m) * NMOD, 3, lane); } SEAM(7);
    if (IN(8)) { pg8::Gemm g{XN, (const bf16*)(ws + WS_WUP), MTOK, NUP, DM}; pg8::StaticOrder S; S.init(MTOK, NUP, G, bx);
        pg8::EpiStoreBf16 E{(bf16*)(ws + WS_U), NUP}; pg8::gemm_phase<pg8::EpiStoreBf16, pg8::StaticOrder, true, true>(lds + RING_OFF, g, S, E); } SEAM(8);
    if (IN(9)) { for (int m = gw; m < MTOK; m += NGW) e3_row(args, m, lane); } SEAM(9);
    if (IN(10)) { pg8::Gemm g{(const bf16*)(ws + WS_ACT), (const bf16*)(ws + WS_WD), MTOK, DM, DFF}; pg8::StaticOrder S; S.init(MTOK, DM, G, bx);
        pg8::EpiResid E{Y, Y + (size_t)NCTX * DM, Y, MOD + 5 * DM}; pg8::gemm_phase<pg8::EpiResid, pg8::StaticOrder, true, true>(lds + RING_OFF, g, S, E); }
#undef IN
#undef SEAM
}

extern "C" void kernel_launch(void* const* d_in, const int* in_sizes, int n_in, void* d_out, int out_size, void* d_ws, size_t ws_size, hipStream_t stream) {
    static int grid = 0;
    if (grid == 0) {
        if (n_in != 23 || ws_size < WS_END) { fprintf(stderr, "kernel_launch: unexpected n_in %d / ws %zu\n", n_in, ws_size); grid = -1; return; }
        int dev = 0, cus = 0, per_cu = 0;
        if (hipGetDevice(&dev) != hipSuccess || hipDeviceGetAttribute(&cus, hipDeviceAttributeMultiprocessorCount, dev) != hipSuccess) { grid = -1; return; }
        if (hipFuncSetAttribute((const void*)fwd_kernel, hipFuncAttributeMaxDynamicSharedMemorySize, LDS_BYTES) != hipSuccess) { fprintf(stderr, "kernel_launch: hipFuncSetAttribute failed\n"); grid = -1; return; }
        if (hipOccupancyMaxActiveBlocksPerMultiprocessor(&per_cu, (const void*)fwd_kernel, NWAVES * 64, LDS_BYTES) != hipSuccess || per_cu < 1) { fprintf(stderr, "kernel_launch: occupancy query says %d\n", per_cu); (void)hipGetLastError(); grid = -1; return; }
        grid = cus;
        if (grid % 8) grid -= grid % 8;
    }
    if (grid < 0) return;
    (void)hipMemsetAsync((char*)d_ws + WS_CTL, 0, CTL_ZERO_BYTES, stream);
    Args a{};
    for (int i = 0; i < 23; ++i) a.in[i] = (const float*)d_in[i];
    a.out = (float*)d_out; a.ws = (unsigned char*)d_ws;
#if MK_PER_PHASE
    for (int p = 0; p < NPH; ++p) { a.ph_lo = p; a.ph_hi = p + 1; hipLaunchKernelGGL(fwd_kernel, dim3(grid), dim3(NWAVES * 64), LDS_BYTES, stream, a); }
#else
    a.ph_lo = 0; a.ph_hi = NPH;
    void* kargs[] = {&a};
    hipError_t e = hipLaunchCooperativeKernel((const void*)fwd_kernel, dim3(grid), dim3(NWAVES * 64), kargs, LDS_BYTES, stream);
    if (e != hipSuccess) fprintf(stderr, "kernel_launch: cooperative launch failed: %s (grid %d)\n", hipGetErrorString(e), grid);
#endif
}
```

```cpp
#include <hip/hip_runtime.h>
#include <cstdio>
#include <cstdint>
#ifndef MK_PER_PHASE
#define MK_PER_PHASE 0
#endif
namespace pg8 {
#define PG8_LAS __attribute__((address_space(3)))
typedef unsigned short bf16_t;
typedef short bf16x8 __attribute__((ext_vector_type(8)));
typedef float f32x4 __attribute__((ext_vector_type(4)));
typedef unsigned u32x4 __attribute__((ext_vector_type(4)));
constexpr int BM = 256, BK = 64, HALF = 128, HTB = HALF * BK * 2  , STAGE_BYTES = 8 * HTB, NXCD = 8, WGM = 8;

__host__ __device__ __forceinline__ int lds_byte(int r, int c) { const int st = (r >> 4) * 2 + (c >> 5), rr = r & 15, cc = c & 31, ob = rr * 64 + cc * 2; return st * 1024 + (ob ^ (((ob >> 9) & 1) << 5)); }
__host__ __device__ __forceinline__ void stage_rc(int b, int& R, int& C) { const int st = b / 1024, sb = b % 1024, swz = sb ^ (((sb >> 9) & 1) << 5); R = (st >> 1) * 16 + swz / 64; C = (st & 1) * 32 + (swz % 64) / 2; }
__host__ __device__ __forceinline__ int perm32(int rho) { const int n = rho >> 4, i = rho & 15; return 8 * (i >> 2) + 4 * n + (i & 3); }

struct Unit { int pm, pn, arow; };
struct Gemm { const bf16_t* A; const bf16_t* Bt; int M, N, K; };

struct StaticOrder {
    int nM, nN, nwg, G, c;
    __host__ __device__ void init(int M, int N, int G_, int c_) { nM = M / BM; nN = N / BM; nwg = nM * nN; G = G_; c = c_; }
    __host__ __device__ bool next(int i, Unit& u) const {
        const long L = (long)i * G + c; if (L >= nwg) return false;
        int wgid = (int)L; { const int q = nwg / NXCD, r = nwg % NXCD, xcd = wgid % NXCD, off = wgid / NXCD; wgid = (xcd < r ? xcd * (q + 1) : r * (q + 1) + (xcd - r) * q) + off; }
        const int nig = WGM * nN, gid = wgid / nig, fm = gid * WGM, gsz = (nM - fm) < WGM ? (nM - fm) : WGM;
        u.pm = fm + ((wgid % nig) % gsz); u.pn = (wgid % nig) / gsz; u.arow = u.pm * BM; return true;
    }
    __device__ __forceinline__ void a_ready(const Unit&) const {}
    __device__ __forceinline__ void done(const Unit&) const {}
};

typedef float f32x2_t __attribute__((ext_vector_type(2))); typedef __bf16 bf16x2_t __attribute__((ext_vector_type(2)));
__device__ __forceinline__ unsigned cvt_pk_bf16(float lo, float hi) { f32x2_t v = {lo, hi}; bf16x2_t b = __builtin_convertvector(v, bf16x2_t); return __builtin_bit_cast(unsigned, b); }
__device__ __forceinline__ float bf_lo(unsigned w) { return __uint_as_float(w << 16); }
__device__ __forceinline__ float bf_hi(unsigned w) { return __uint_as_float(w & 0xffff0000u); }
__device__ __forceinline__ float sigmoidf_(float x) { return __builtin_amdgcn_rcpf(1.0f + __builtin_amdgcn_exp2f(-1.4426950408889634f * x)); }

struct EpiStoreBf16 {
    static constexpr bool PERM = true, AFTER_DRAIN = false, APERM = false;
    bf16_t* O; int ldc;
    __device__ __forceinline__ void operator()(const f32x4 (&acc)[2][2][4][2], const Unit& u, int wr, int wc, int fr, int fq) const {
        const int row0 = u.pm * BM + wr * 64 + fr, col0 = u.pn * BM + wc * 32 + 8 * fq;
#pragma unroll
        for (int ai = 0; ai < 2; ++ai)
#pragma unroll
            for (int m = 0; m < 4; ++m) { bf16_t* rowp = O + (size_t)(row0 + ai * HALF + m * 16) * ldc + col0;
#pragma unroll
                for (int bj = 0; bj < 2; ++bj) { const f32x4 v0 = acc[ai][bj][m][0], v1 = acc[ai][bj][m][1];
                    u32x4 w; w.x = cvt_pk_bf16(v0[0], v0[1]); w.y = cvt_pk_bf16(v0[2], v0[3]); w.z = cvt_pk_bf16(v1[0], v1[1]); w.w = cvt_pk_bf16(v1[2], v1[3]);
                    *(u32x4*)(rowp + bj * HALF) = w; } }
    }
};
struct EpiMerge {
    static constexpr bool PERM = true, AFTER_DRAIN = false, APERM = false;
    const bf16_t* T1; const bf16_t* Z; bf16_t* O;
    __device__ __forceinline__ void operator()(const f32x4 (&acc)[2][2][4][2], const Unit& u, int wr, int wc, int fr, int fq) const {
        const int row0 = u.pm * BM + wr * 64 + fr, col0 = u.pn * BM + wc * 32 + 8 * fq;
        u32x4 pt[2][2], pp[2][2], pn_[2][2];
#define MG_LOAD(slot, grp) do { const size_t row_ = (size_t)(row0 + ((grp) >> 2) * HALF + ((grp) & 3) * 16); \
            _Pragma("unroll") for (int bj = 0; bj < 2; ++bj) { const int col_ = col0 + bj * HALF; pt[slot][bj] = *(const u32x4*)(T1 + row_ * 1024 + col_); pp[slot][bj] = *(const u32x4*)(Z + row_ * 4096 + 2048 + col_); pn_[slot][bj] = *(const u32x4*)(Z + row_ * 4096 + 3072 + col_); } } while (0)
        MG_LOAD(0, 0); MG_LOAD(1, 1);
#pragma unroll
        for (int grp = 0; grp < 8; ++grp) { const int ai = grp >> 2, m = grp & 3, sl = grp & 1; const size_t row = (size_t)(row0 + ai * HALF + m * 16);
            u32x4 w[2];
#pragma unroll
            for (int bj = 0; bj < 2; ++bj) { const u32x4 t = pt[sl][bj], gp = pp[sl][bj], gn = pn_[sl][bj]; const f32x4 v0 = acc[ai][bj][m][0], v1 = acc[ai][bj][m][1];
                w[bj].x = cvt_pk_bf16(sigmoidf_(bf_lo(gp.x)) * bf_lo(t.x) + sigmoidf_(bf_lo(gn.x)) * v0[0], sigmoidf_(bf_hi(gp.x)) * bf_hi(t.x) + sigmoidf_(bf_hi(gn.x)) * v0[1]);
                w[bj].y = cvt_pk_bf16(sigmoidf_(bf_lo(gp.y)) * bf_lo(t.y) + sigmoidf_(bf_lo(gn.y)) * v0[2], sigmoidf_(bf_hi(gp.y)) * bf_hi(t.y) + sigmoidf_(bf_hi(gn.y)) * v0[3]);
                w[bj].z = cvt_pk_bf16(sigmoidf_(bf_lo(gp.z)) * bf_lo(t.z) + sigmoidf_(bf_lo(gn.z)) * v1[0], sigmoidf_(bf_hi(gp.z)) * bf_hi(t.z) + sigmoidf_(bf_hi(gn.z)) * v1[1]);
                w[bj].w = cvt_pk_bf16(sigmoidf_(bf_lo(gp.w)) * bf_lo(t.w) + sigmoidf_(bf_lo(gn.w)) * v1[2], sigmoidf_(bf_hi(gp.w)) * bf_hi(t.w) + sigmoidf_(bf_hi(gn.w)) * v1[3]); }
            if (grp + 2 < 8) { if (sl == 0) MG_LOAD(0, grp + 2); else MG_LOAD(1, grp + 2); }
            asm volatile("" ::: "memory");
#pragma unroll
            for (int bj = 0; bj < 2; ++bj) *(u32x4*)(O + row * 1024 + col0 + bj * HALF) = w[bj]; }
#undef MG_LOAD
    }
};
struct EpiResid {
    static constexpr bool PERM = false, AFTER_DRAIN = false, APERM = false;
    const float* base0; const float* base1; float* out; const float* gate;
    __device__ __forceinline__ void operator()(const f32x4 (&acc)[2][2][4][2], const Unit& u, int wr, int wc, int fr, int fq) const {
        const int trow = u.pm * BM, row0 = trow + wr * 64 + fr, col0 = u.pn * BM + wc * 32 + 4 * fq;
        const int mi = trow < 8192 ? 0 : 1 + ((trow - 8192) >> 11);
        const float* bp = trow < 8192 ? base0 : base1 - (size_t)8192 * 1024;
        f32x4 g[2][2];
#pragma unroll
        for (int bj = 0; bj < 2; ++bj)
#pragma unroll
            for (int n = 0; n < 2; ++n) g[bj][n] = *(const f32x4*)(gate + mi * 6144 + col0 + bj * HALF + n * 16);
        f32x4 pre[4][2][2];
#define RS_LOAD(slot, grp) do { const size_t off_ = (size_t)(row0 + ((grp) >> 2) * HALF + ((grp) & 3) * 16) * 1024 + col0; \
            _Pragma("unroll") for (int bj = 0; bj < 2; ++bj) _Pragma("unroll") for (int n = 0; n < 2; ++n) pre[slot][bj][n] = *(const f32x4*)(bp + off_ + bj * HALF + n * 16); } while (0)
        RS_LOAD(0, 0); RS_LOAD(1, 1); RS_LOAD(2, 2); RS_LOAD(3, 3);
#pragma unroll
        for (int grp = 0; grp < 8; ++grp) { const int ai = grp >> 2, m = grp & 3, sl = grp & 3; const size_t off = (size_t)(row0 + ai * HALF + m * 16) * 1024 + col0;
            f32x4 r[2][2];
#pragma unroll
            for (int bj = 0; bj < 2; ++bj)
#pragma unroll
                for (int n = 0; n < 2; ++n) r[bj][n] = pre[sl][bj][n] + g[bj][n] * acc[ai][bj][m][n];
            if (grp + 4 < 8) { if (sl == 0) RS_LOAD(0, grp + 4); else if (sl == 1) RS_LOAD(1, grp + 4); else if (sl == 2) RS_LOAD(2, grp + 4); else RS_LOAD(3, grp + 4); }
            asm volatile("" ::: "memory");
#pragma unroll
            for (int bj = 0; bj < 2; ++bj)
#pragma unroll
                for (int n = 0; n < 2; ++n) *(f32x4*)(out + off + bj * HALF + n * 16) = r[bj][n]; }
#undef RS_LOAD
    }
};

__host__ __device__ __forceinline__ int up_arow(int pm) { if (pm < 32) return pm * 256; const int q = pm - 32, seq = q / 9, k = q % 9; int st = 254 * k; if (st > 1792) st = 1792; return 8192 + seq * 2048 + st; }
struct UpOrder : StaticOrder {
    __host__ __device__ bool next(int i, Unit& u) const { if (!StaticOrder::next(i, u)) return false; u.arow = up_arow(u.pm); return true; }
};
__device__ __forceinline__ float siluf__(float x) { return x * __builtin_amdgcn_rcpf(1.0f + __builtin_amdgcn_exp2f(-1.4426950408889634f * x)); }
struct EpiConvGate {
    static constexpr bool PERM = true, AFTER_DRAIN = false, APERM = true;
    bf16_t* ACT; const float* rowss; const float* bup; const float* cw; const float* cb; PG8_LAS float* xch;
    __device__ __forceinline__ void operator()(f32x4 (&acc)[2][2][4][2], const Unit& u, int wr, int wc, int fr, int fq) const {
        const int pm = u.pm; int wlo = 0, whi = 255;
        if (pm >= 32) { const int k = (pm - 32) % 9; if (k == 0) whi = 254; else if (k < 8) { wlo = 1; whi = 254; } else wlo = 241; }
        const int mi = pm < 32 ? 0 : 1 + (pm - 32) / 9;
        const int tok0 = u.arow, cbase = 32 * wc + 8 * fq, ca = 128 * u.pn + cbase;
        f32x4 w0[2], w1[2], w2[2], bb[2];
#pragma unroll
        for (int bj = 0; bj < 2; ++bj) { const int col = bj * 2816 + ca; w0[bj] = *(const f32x4*)(cw + col); w1[bj] = *(const f32x4*)(cw + 5632 + col); w2[bj] = *(const f32x4*)(cw + 2 * 5632 + col); bb[bj] = *(const f32x4*)(cb + col); }
        {   f32x4 rs[2];
#pragma unroll
            for (int ai = 0; ai < 2; ++ai) { const f32x4 ss = *(const f32x4*)(rowss + tok0 + 128 * ai + 64 * wr + 4 * fr);
#pragma unroll
                for (int m = 0; m < 4; ++m) rs[ai][m] = 1.0f / sqrtf(ss[m] * (1.0f / 1024.0f) + 1e-6f); }
#pragma unroll
            for (int bj = 0; bj < 2; ++bj)
#pragma unroll
                for (int n = 0; n < 2; ++n) { const f32x4 b = *(const f32x4*)(bup + mi * 5632 + bj * 2816 + ca + 4 * n);
#pragma unroll
                    for (int ai = 0; ai < 2; ++ai)
#pragma unroll
                        for (int m = 0; m < 4; ++m) acc[ai][bj][m][n] = acc[ai][bj][m][n] * rs[ai][m] + b; } }
        if (fr == 0 || fr == 15) { const int wh = fr == 0 ? 0 : 1;
#pragma unroll
            for (int ai = 0; ai < 2; ++ai)
#pragma unroll
                for (int bj = 0; bj < 2; ++bj)
#pragma unroll
                    for (int n = 0; n < 2; ++n) *(PG8_LAS f32x4*)(xch + ((2 * ai + wr) * 2 + wh) * 256 + 128 * bj + cbase + 4 * n) = fr == 0 ? acc[ai][bj][0][n] : acc[ai][bj][3][n]; }
        asm volatile("s_waitcnt lgkmcnt(0)" ::: "memory"); __builtin_amdgcn_s_barrier(); asm volatile("" ::: "memory");
        const f32x4 zero4 = {0.f, 0.f, 0.f, 0.f};
        typedef unsigned u32x2 __attribute__((ext_vector_type(2)));
#pragma unroll
        for (int n = 0; n < 2; ++n) {
            if (n == 1) {
#pragma unroll
                for (int bj = 0; bj < 2; ++bj) { const int col = bj * 2816 + ca + 4; w0[bj] = *(const f32x4*)(cw + col); w1[bj] = *(const f32x4*)(cw + 5632 + col); w2[bj] = *(const f32x4*)(cw + 2 * 5632 + col); bb[bj] = *(const f32x4*)(cb + col); } }
#pragma unroll
            for (int ai = 0; ai < 2; ++ai) { const int c = 2 * ai + wr;
                f32x4 r[4][2];
#pragma unroll
                for (int bj = 0; bj < 2; ++bj) {
                    const f32x4 P = c > 0 ? *(const PG8_LAS f32x4*)(xch + ((c - 1) * 2 + 1) * 256 + 128 * bj + cbase + 4 * n) : zero4;
                    const f32x4 Nx = c < 3 ? *(const PG8_LAS f32x4*)(xch + ((c + 1) * 2 + 0) * 256 + 128 * bj + cbase + 4 * n) : zero4;
                    const f32x4 c0 = acc[ai][bj][0][n], c1 = acc[ai][bj][1][n], c2 = acc[ai][bj][2][n], c3 = acc[ai][bj][3][n];
                    f32x4 up0, dn3;
#pragma unroll
                    for (int e = 0; e < 4; ++e) { up0[e] = __int_as_float(__builtin_amdgcn_update_dpp(__float_as_int(P[e]), __float_as_int(c3[e]), 0x111, 0xf, 0xf, false));
                        dn3[e] = __int_as_float(__builtin_amdgcn_update_dpp(__float_as_int(Nx[e]), __float_as_int(c0[e]), 0x101, 0xf, 0xf, false)); }
                    r[0][bj] = w0[bj] * up0 + w1[bj] * c0 + w2[bj] * c1 + bb[bj];
                    r[1][bj] = w0[bj] * c0 + w1[bj] * c1 + w2[bj] * c2 + bb[bj];
                    r[2][bj] = w0[bj] * c1 + w1[bj] * c2 + w2[bj] * c3 + bb[bj];
                    r[3][bj] = w0[bj] * c2 + w1[bj] * c3 + w2[bj] * dn3 + bb[bj]; }
#pragma unroll
                for (int m = 0; m < 4; ++m) { const int row = 128 * ai + 64 * wr + 4 * fr + m;
                    u32x2 o; o.x = cvt_pk_bf16(siluf__(r[m][0][0]) * r[m][1][0], siluf__(r[m][0][1]) * r[m][1][1]); o.y = cvt_pk_bf16(siluf__(r[m][0][2]) * r[m][1][2], siluf__(r[m][0][3]) * r[m][1][3]);
                    if (row >= wlo && row <= whi) *(u32x2*)(ACT + (size_t)(tok0 + row) * 2816 + ca + 4 * n) = o; } } }
    }
};
struct EpiResidNorm {
    static constexpr bool PERM = false, AFTER_DRAIN = false, APERM = false;
    const float* base0; const float* base1; float* out; const float* gate; const float* gnorm; const float* scale; bf16_t* XS; float* rowss;
    __device__ __forceinline__ void operator()(const f32x4 (&acc)[2][2][4][2], const Unit& u, int wr, int wc, int fr, int fq) const {
        const int trow = u.pm * BM, row0 = trow + wr * 64 + fr, col0 = u.pn * BM + wc * 32 + 4 * fq;
        const int mi = trow < 8192 ? 0 : 1 + ((trow - 8192) >> 11);
        const float* bp = trow < 8192 ? base0 : base1 - (size_t)8192 * 1024;
        f32x4 g[2][2], gm[2][2];
#pragma unroll
        for (int bj = 0; bj < 2; ++bj)
#pragma unroll
            for (int n = 0; n < 2; ++n) { const int c = col0 + bj * HALF + n * 16; g[bj][n] = *(const f32x4*)(gate + mi * 6144 + c); gm[bj][n] = *(const f32x4*)(gnorm + c) * (*(const f32x4*)(scale + mi * 6144 + c) + 1.0f); }
        f32x4 pre[3][2][2];
#define RN_LOAD(slot, grp) do { const size_t off_ = (size_t)(row0 + ((grp) >> 2) * HALF + ((grp) & 3) * 16) * 1024 + col0; \
            _Pragma("unroll") for (int bj = 0; bj < 2; ++bj) _Pragma("unroll") for (int n = 0; n < 2; ++n) pre[slot][bj][n] = *(const f32x4*)(bp + off_ + bj * HALF + n * 16); } while (0)
        RN_LOAD(0, 0); RN_LOAD(1, 1); RN_LOAD(2, 2);
        typedef unsigned u32x2 __attribute__((ext_vector_type(2)));
#pragma unroll
        for (int grp = 0; grp < 8; ++grp) { const int ai = grp >> 2, m = grp & 3, sl = grp % 3; const size_t off = (size_t)(row0 + ai * HALF + m * 16) * 1024 + col0; float ss = 0.f;
            f32x4 x1[2][2]; u32x2 o[2][2];
#pragma unroll
            for (int bj = 0; bj < 2; ++bj)
#pragma unroll
                for (int n = 0; n < 2; ++n) { x1[bj][n] = pre[sl][bj][n] + g[bj][n] * acc[ai][bj][m][n]; const f32x4 v = x1[bj][n]; ss += (v[0] * v[0] + v[1] * v[1]) + (v[2] * v[2] + v[3] * v[3]);
                    const f32x4 xs = v * gm[bj][n]; o[bj][n].x = cvt_pk_bf16(xs[0], xs[1]); o[bj][n].y = cvt_pk_bf16(xs[2], xs[3]); }
            if (grp + 3 < 8) { if (sl == 0) RN_LOAD(0, grp + 3); else if (sl == 1) RN_LOAD(1, grp + 3); else RN_LOAD(2, grp + 3); }
            asm volatile("" ::: "memory");
#pragma unroll
            for (int bj = 0; bj < 2; ++bj)
#pragma unroll
                for (int n = 0; n < 2; ++n) { *(f32x4*)(out + off + bj * HALF + n * 16) = x1[bj][n]; *(u32x2*)(XS + off + bj * HALF + n * 16) = o[bj][n]; }
            ss += __shfl_xor(ss, 16); ss += __shfl_xor(ss, 32);
            if (fq == 0) atomicAdd(rowss + row0 + ai * HALF + m * 16, ss); }
#undef RN_LOAD
    }
};

struct EpiQKV {
    static constexpr bool PERM = true, AFTER_DRAIN = false, APERM = false;
    bf16_t* Z; const float* qg; const float* kg; float* newk; float* newv;
    __device__ __forceinline__ void operator()(const f32x4 (&acc)[2][2][4][2], const Unit& u, int wr, int wc, int fr, int fq) const {
        const int row0 = u.pm * BM + wr * 64 + fr, pn = u.pn;
        if (pn < 2 || pn >= 8) {
            const int col0 = pn * BM + wc * 32 + 8 * fq;
#pragma unroll
            for (int ai = 0; ai < 2; ++ai)
#pragma unroll
                for (int m = 0; m < 4; ++m) { bf16_t* rowp = Z + (size_t)(row0 + ai * HALF + m * 16) * 4096 + col0;
#pragma unroll
                    for (int bj = 0; bj < 2; ++bj) { const f32x4 v0 = acc[ai][bj][m][0], v1 = acc[ai][bj][m][1];
                        u32x4 w; w.x = cvt_pk_bf16(v0[0], v0[1]); w.y = cvt_pk_bf16(v0[2], v0[3]); w.z = cvt_pk_bf16(v1[0], v1[1]); w.w = cvt_pk_bf16(v1[2], v1[3]);
                        *(u32x4*)(rowp + bj * HALF) = w; } }
            return;
        }
        const int kind = (pn - 2) >> 1, h = 4 * (pn & 1) + wc;
        const int zc = 512 + kind * 512 + h * 64 + 8 * fq;
        const float* gp = kind == 0 ? qg : kg;
        const float qs = kind == 0 ? 0.125f * 1.4426950408889634f : 1.0f;
        f32x4 g0[2], g1[2];
#pragma unroll
        for (int bj = 0; bj < 2; ++bj) { g0[bj] = *(const f32x4*)(gp + 32 * bj + 8 * fq); g1[bj] = *(const f32x4*)(gp + 32 * bj + 8 * fq + 4); }
#pragma unroll
        for (int ai = 0; ai < 2; ++ai)
#pragma unroll
            for (int m = 0; m < 4; ++m) { const int row = row0 + ai * HALF + m * 16;
                f32x4 v[2][2];
#pragma unroll
                for (int bj = 0; bj < 2; ++bj)
#pragma unroll
                    for (int n = 0; n < 2; ++n) v[bj][n] = acc[ai][bj][m][n];
                if (kind < 2) { float ss = 0.f;
#pragma unroll
                    for (int bj = 0; bj < 2; ++bj)
#pragma unroll
                        for (int n = 0; n < 2; ++n) ss += (v[bj][n][0] * v[bj][n][0] + v[bj][n][1] * v[bj][n][1]) + (v[bj][n][2] * v[bj][n][2] + v[bj][n][3] * v[bj][n][3]);
                    ss += __shfl_xor(ss, 16); ss += __shfl_xor(ss, 32);
                    const float rstd = 1.0f / sqrtf(ss * (1.0f / 64.0f) + 1e-6f);
#pragma unroll
                    for (int bj = 0; bj < 2; ++bj) { v[bj][0] = v[bj][0] * (rstd * qs) * g0[bj]; v[bj][1] = v[bj][1] * (rstd * qs) * g1[bj]; } }
#pragma unroll
                for (int bj = 0; bj < 2; ++bj) { u32x4 w; w.x = cvt_pk_bf16(v[bj][0][0], v[bj][0][1]); w.y = cvt_pk_bf16(v[bj][0][2], v[bj][0][3]); w.z = cvt_pk_bf16(v[bj][1][0], v[bj][1][1]); w.w = cvt_pk_bf16(v[bj][1][2], v[bj][1][3]);
                    *(u32x4*)(Z + (size_t)row * 4096 + zc + 32 * bj) = w; }
                if (kind >= 1 && row < 8192) { float* op = (kind == 1 ? newk : newv) + ((size_t)((row >> 8) * 8 + h) * 256 + (row & 255)) * 64 + 8 * fq;
#pragma unroll
                    for (int bj = 0; bj < 2; ++bj) { *(f32x4*)(op + 32 * bj) = v[bj][0]; *(f32x4*)(op + 32 * bj + 4) = v[bj][1]; } } }
    }
};

template <class Epi, class Sched, bool ALIGN_EPI = false, bool SP2 = false>
__device__ __forceinline__ void gemm_phase(PG8_LAS unsigned char* lds, const Gemm g, const Sched& S, const Epi& E) {
    const int tid = threadIdx.x, wid = __builtin_amdgcn_readfirstlane(tid >> 6), lane = tid & 63, wr = wid >> 2, wc = wid & 3, fr = lane & 15, fq = lane >> 4;
    const int K = g.K, nt = K / BK;
    unsigned voffA[2], voffB[2];
#pragma unroll
    for (int i = 0; i < 2; ++i) { int R, C; stage_rc(tid * 16 + i * 8192, R, C); const int Rb = Epi::PERM ? ((R & ~31) + perm32(R & 31)) : R;
        const int Ra = Epi::APERM ? ((R & ~63) + 4 * (R & 15) + ((R >> 4) & 3)) : R;
        voffA[i] = (unsigned)(Ra * K + C) * 2u; voffB[i] = (unsigned)(Rb * K + C) * 2u; }
    const size_t kstep = (size_t)(BK * 2);
    const size_t hstep = (size_t)HALF * K * 2;
    const size_t tstep = 2 * hstep;
    const unsigned ldsw = (unsigned)wid * 1024u;
    const int aoff = lds_byte(wr * 64 + fr, fq * 8), boff = lds_byte(wc * 32 + fr, fq * 8);
#define PG8_SA(b, h) (((b) * 2 + (h)) * HTB)
#define PG8_SB(b, h) ((4 + (b) * 2 + (h)) * HTB)
#define PG8_STAGE(bufoff, gbase, voff) do { _Pragma("unroll") for (int _i = 0; _i < 2; ++_i) \
        __builtin_amdgcn_global_load_lds((const unsigned*)((const char*)(gbase) + (voff)[_i]), (PG8_LAS unsigned*)(lds + (bufoff) + ldsw + _i * 8192), 16, 0, 0); } while (0)
#define PG8_LDA(dst, b, h) do { _Pragma("unroll") for (int m = 0; m < 4; ++m) _Pragma("unroll") for (int k = 0; k < 2; ++k) dst[m][k] = *(const PG8_LAS bf16x8*)(lds + PG8_SA(b, h) + aoff + m * 2048 + k * 1024); } while (0)
#define PG8_LDB(dst, b, h) do { _Pragma("unroll") for (int n = 0; n < 2; ++n) _Pragma("unroll") for (int k = 0; k < 2; ++k) dst[n][k] = *(const PG8_LAS bf16x8*)(lds + PG8_SB(b, h) + boff + n * 2048 + k * 1024); } while (0)
#define PG8_MMA(ai, bj, At, Bt) do { __builtin_amdgcn_s_setprio(1); _Pragma("unroll") for (int m = 0; m < 4; ++m) _Pragma("unroll") for (int n = 0; n < 2; ++n) _Pragma("unroll") for (int k = 0; k < 2; ++k) \
        acc[ai][bj][m][n] = __builtin_amdgcn_mfma_f32_16x16x32_bf16(Bt[n][k], At[m][k], acc[ai][bj][m][n], 0, 0, 0); __builtin_amdgcn_s_setprio(0); } while (0)
#define PG8_WAIT_V(n) asm volatile("s_waitcnt vmcnt(" #n ")" ::: "memory")
#define PG8_WAIT_L(n) asm volatile("s_waitcnt lgkmcnt(" #n ")" ::: "memory")
#define PG8_BAR __builtin_amdgcn_s_barrier()
#define PG8_SCHED __builtin_amdgcn_sched_barrier(0)
    Unit cur, nxt; int ui = 0;
    if (!S.next(0, cur)) return;
    f32x4 acc[2][2][4][2];
#pragma unroll
    for (int a = 0; a < 2; ++a)
#pragma unroll
        for (int b = 0; b < 2; ++b)
#pragma unroll
            for (int m = 0; m < 4; ++m)
#pragma unroll
                for (int n = 0; n < 2; ++n) acc[a][b][m][n] = (f32x4){0.f, 0.f, 0.f, 0.f};
    bf16x8 At[4][2], B0[2][2], B1[2][2];
    const size_t rowb = (size_t)K * 2; const char* cA = (const char*)g.A + (size_t)cur.arow * rowb; const char* cB = (const char*)g.Bt + (size_t)cur.pn * tstep;
    S.a_ready(cur);
    if constexpr (SP2) {
        PG8_STAGE(PG8_SB(0, 0), cB, voffB); PG8_STAGE(PG8_SB(0, 1), cB + hstep, voffB); PG8_STAGE(PG8_SA(0, 0), cA, voffA); PG8_STAGE(PG8_SA(0, 1), cA + hstep, voffA);
        if (wr == 1) PG8_BAR;
        PG8_WAIT_V(2); PG8_BAR;
        PG8_STAGE(PG8_SB(1, 0), cB + kstep, voffB); PG8_STAGE(PG8_SA(1, 0), cA + kstep, voffA); PG8_STAGE(PG8_SB(1, 1), cB + hstep + kstep, voffB);
        PG8_WAIT_V(6); PG8_BAR;
    } else {
        PG8_STAGE(PG8_SB(0, 0), cB, voffB); PG8_STAGE(PG8_SA(0, 0), cA, voffA); PG8_STAGE(PG8_SB(0, 1), cB + hstep, voffB); PG8_STAGE(PG8_SA(0, 1), cA + hstep, voffA);
        if (wr == 1) PG8_BAR;
        PG8_WAIT_V(4); PG8_BAR;
        PG8_STAGE(PG8_SB(1, 0), cB + kstep, voffB); PG8_STAGE(PG8_SA(1, 0), cA + kstep, voffA); PG8_STAGE(PG8_SB(1, 1), cB + hstep + kstep, voffB);
        PG8_WAIT_V(6); PG8_BAR;
    }
    for (;;) {
        const bool has_next = S.next(ui + 1, nxt);
        const char* nA = has_next ? (const char*)g.A + (size_t)nxt.arow * rowb : cA; const char* nB = has_next ? (const char*)g.Bt + (size_t)nxt.pn * tstep : cB;
        for (int t = 0; t < nt; t += 2) {
            const bool last = (t == nt - 2);
            const char* a1 = cA + (size_t)(t + 1) * kstep;
            const char* a2 = last ? nA : cA + (size_t)(t + 2) * kstep; const char* b2 = last ? nB : cB + (size_t)(t + 2) * kstep;
            const char* a3 = a2 + kstep; const char* b3 = b2 + kstep;
            if (last && has_next) S.a_ready(nxt);
            if constexpr (SP2) {
            PG8_LDB(B0, 0, 0); PG8_LDB(B1, 0, 1); PG8_SCHED; PG8_LDA(At, 0, 0); PG8_STAGE(PG8_SA(1, 1), a1 + hstep, voffA);
            PG8_WAIT_V(8); PG8_WAIT_L(0); PG8_BAR; PG8_MMA(0, 0, At, B0); PG8_MMA(0, 1, At, B1); PG8_BAR; PG8_SCHED;
            PG8_LDA(At, 0, 1); PG8_STAGE(PG8_SB(0, 0), b2, voffB); PG8_STAGE(PG8_SB(0, 1), b2 + hstep, voffB); PG8_STAGE(PG8_SA(0, 0), a2, voffA);
            PG8_WAIT_V(8); PG8_WAIT_L(0); PG8_BAR; PG8_MMA(1, 0, At, B0); PG8_MMA(1, 1, At, B1); PG8_BAR; PG8_SCHED;
            PG8_LDB(B0, 1, 0); PG8_LDB(B1, 1, 1); PG8_SCHED; PG8_LDA(At, 1, 0); PG8_STAGE(PG8_SA(0, 1), a2 + hstep, voffA);
            PG8_WAIT_V(8); PG8_WAIT_L(0); PG8_BAR; PG8_MMA(0, 0, At, B0); PG8_MMA(0, 1, At, B1); PG8_BAR; PG8_SCHED;
            PG8_LDA(At, 1, 1); PG8_STAGE(PG8_SB(1, 0), b3, voffB); PG8_STAGE(PG8_SB(1, 1), b3 + hstep, voffB); PG8_STAGE(PG8_SA(1, 0), a3, voffA);
            PG8_WAIT_V(8); PG8_WAIT_L(0); PG8_BAR; PG8_MMA(1, 0, At, B0); PG8_MMA(1, 1, At, B1); PG8_BAR; PG8_SCHED;
            } else {
            PG8_LDB(B0, 0, 0); PG8_SCHED; PG8_LDA(At, 0, 0); PG8_STAGE(PG8_SA(1, 1), a1 + hstep, voffA);
            PG8_WAIT_L(8); PG8_BAR; PG8_WAIT_L(0); PG8_MMA(0, 0, At, B0); PG8_BAR; PG8_SCHED;
            PG8_LDB(B1, 0, 1); PG8_STAGE(PG8_SB(0, 0), b2, voffB);
            PG8_BAR; PG8_WAIT_L(0); PG8_MMA(0, 1, At, B1); PG8_BAR;
            PG8_LDA(At, 0, 1); PG8_STAGE(PG8_SA(0, 0), a2, voffA);
            PG8_BAR; PG8_WAIT_L(0); PG8_MMA(1, 0, At, B0); PG8_BAR; PG8_SCHED;
            PG8_STAGE(PG8_SB(0, 1), b2 + hstep, voffB);
            PG8_WAIT_V(6); PG8_BAR; PG8_MMA(1, 1, At, B1); PG8_BAR;
            PG8_LDB(B0, 1, 0); PG8_SCHED; PG8_LDA(At, 1, 0); PG8_STAGE(PG8_SA(0, 1), a2 + hstep, voffA);
            PG8_WAIT_L(8); PG8_BAR; PG8_WAIT_L(0); PG8_MMA(0, 0, At, B0); PG8_BAR; PG8_SCHED;
            PG8_LDB(B1, 1, 1); PG8_STAGE(PG8_SB(1, 0), b3, voffB);
            PG8_BAR; PG8_WAIT_L(0); PG8_MMA(0, 1, At, B1); PG8_BAR;
            PG8_LDA(At, 1, 1); PG8_STAGE(PG8_SA(1, 0), a3, voffA);
            PG8_BAR; PG8_WAIT_L(0); PG8_MMA(1, 0, At, B0); PG8_BAR; PG8_SCHED;
            PG8_STAGE(PG8_SB(1, 1), b3 + hstep, voffB);
            PG8_WAIT_V(6); PG8_BAR; PG8_MMA(1, 1, At, B1); PG8_BAR;
            }
        }
        if constexpr (ALIGN_EPI) { if (wr == 0) PG8_BAR; }
        if constexpr (!Epi::AFTER_DRAIN) { E(acc, cur, wr, wc, fr, fq); S.done(cur); }
        if (!has_next) break;
#pragma unroll
        for (int a = 0; a < 2; ++a)
#pragma unroll
            for (int b = 0; b < 2; ++b)
#pragma unroll
                for (int m = 0; m < 4; ++m)
#pragma unroll
                    for (int n = 0; n < 2; ++n) acc[a][b][m][n] = (f32x4){0.f, 0.f, 0.f, 0.f};
        cur = nxt; cA = nA; cB = nB; ++ui;
        if constexpr (ALIGN_EPI) { if (wr == 1) PG8_BAR; }
    }
    PG8_WAIT_V(0);
    if constexpr (!ALIGN_EPI) { if (wr == 0) PG8_BAR; }
    PG8_BAR;
    if constexpr (Epi::AFTER_DRAIN) { E.fused(acc, cur, wr, wc, fr, fq, lds, wid, lane); S.done(cur); }
#undef PG8_SA
#undef PG8_SB
#undef PG8_STAGE
#undef PG8_LDA
#undef PG8_LDB
#undef PG8_MMA
#undef PG8_WAIT_V
#undef PG8_WAIT_L
#undef PG8_BAR
#undef PG8_SCHED
}
}
#define GAS __attribute__((address_space(1)))
#define LAS __attribute__((address_space(3)))
typedef unsigned short bf16;
typedef unsigned v4u __attribute__((ext_vector_type(4)));
typedef float f32x4 __attribute__((ext_vector_type(4)));
typedef short bf16x8 __attribute__((ext_vector_type(8)));
typedef GAS unsigned gu32;
typedef GAS unsigned long long gu64;
#define RLX_AGENT __ATOMIC_RELAXED, __HIP_MEMORY_SCOPE_AGENT
#define LDS_WAIT() asm volatile("s_waitcnt lgkmcnt(0)" ::: "memory")
#define VM_WAIT() asm volatile("s_waitcnt vmcnt(0)" ::: "memory")
__device__ __forceinline__ unsigned long long rt() { return __builtin_amdgcn_s_memrealtime(); }
__device__ __forceinline__ unsigned f2bf(float f) { unsigned u = __builtin_bit_cast(unsigned, f); return (u + 0x7fffu + ((u >> 16) & 1u)) >> 16; }
__device__ __forceinline__ unsigned pk2(float lo, float hi) { return f2bf(lo) | (f2bf(hi) << 16); }

#define XB_TMO      128
#define XB_XCNT(j)  (256  + 64 * (j))
#define XB_XSUB(j)  (1280 + 64 * (j))
#define XB_XGEN(j)  (2304 + 64 * (j))
#define XB_TOP      3328
#define XB_TOPGEN   3392
#define XCD_BAR_WORDS 3456
#define XB_SPIN_CAP (1u << 18)

__device__ __forceinline__ unsigned xb_ld(unsigned* p)              { return __hip_atomic_load(p, __ATOMIC_RELAXED, __HIP_MEMORY_SCOPE_AGENT); }
__device__ __forceinline__ unsigned xb_add(unsigned* p, unsigned v) { return __hip_atomic_fetch_add(p, v, __ATOMIC_RELAXED, __HIP_MEMORY_SCOPE_AGENT); }
__device__ __forceinline__ unsigned xb_xcc_id() { return (unsigned)__builtin_amdgcn_s_getreg((3 << 11) | 20) & 0xFu; }
#define XB_SPIN(cond, bar) do { unsigned _sp = 0; while (cond) { __builtin_amdgcn_s_sleep(1); \
    if ((++_sp & 255u) == 0u) { if (xb_ld(&(bar)[XB_TMO])) break; if (_sp > XB_SPIN_CAP) { atomicAdd(&(bar)[XB_TMO], 1u); break; } } } } while (0)

struct XcdBarrier {
    unsigned* bar; unsigned x;
    volatile LAS unsigned* st;
};

__device__ __forceinline__ XcdBarrier xcd_barrier_post(unsigned* bar, volatile LAS unsigned* st) {
    XcdBarrier b; b.bar = bar; b.x = xb_xcc_id(); b.st = st;
    if (threadIdx.x == 0) (void)xb_add(&bar[XB_XCNT(b.x)], 1u);
    return b;
}
__device__ __forceinline__ void xcd_barrier_complete(unsigned* bar, unsigned x, unsigned& nloc, unsigned& nx) {
    const unsigned G = gridDim.x * gridDim.y * gridDim.z;
    unsigned sum, cnt, mine, sp = 0u;
    for (;;) {
        sum = 0u; cnt = 0u; mine = 0u;
#pragma unroll
        for (unsigned j = 0; j < 16; ++j) { const unsigned c = xb_ld(&bar[XB_XCNT(j)]); sum += c; cnt += (c > 0u) ? 1u : 0u; mine = (j == x) ? c : mine; }
        if (sum == G) break;
        __builtin_amdgcn_s_sleep(1);
        if ((++sp & 255u) == 0u) { if (xb_ld(&bar[XB_TMO])) break; if (sp > XB_SPIN_CAP) { atomicAdd(&bar[XB_TMO], 1u); break; } }
    }
    nloc = mine > 0u ? mine : 1u; nx = cnt > 0u ? cnt : 1u;
}

__device__ __forceinline__ void xcd_barrier(const XcdBarrier& b) {
    asm volatile("s_waitcnt vmcnt(0)" ::: "memory");
    __syncthreads();
    if (threadIdx.x == 0) {
        unsigned* bar = b.bar;
        __builtin_amdgcn_s_waitcnt(0);
        unsigned nloc = b.st[0], nx = b.st[1];
        if (nloc == 0u) { xcd_barrier_complete(bar, b.x, nloc, nx); b.st[0] = nloc; b.st[1] = nx; }
        const unsigned old = xb_add(&bar[XB_XSUB(b.x)], 1u);
        const unsigned gen = old / nloc;
        if (old + 1u == (gen + 1u) * nloc) {
            __builtin_amdgcn_fence(__ATOMIC_RELEASE, "agent");
            asm volatile("s_waitcnt vmcnt(0)" ::: "memory");
            const unsigned og = xb_add(&bar[XB_TOP], 1u);
            const unsigned tg = og / nx;
            if (og + 1u == (tg + 1u) * nx) xb_add(&bar[XB_TOPGEN], 1u);
            else XB_SPIN(xb_ld(&bar[XB_TOPGEN]) == tg, bar);
            __builtin_amdgcn_fence(__ATOMIC_ACQUIRE, "agent");
            xb_add(&bar[XB_XGEN(b.x)], 1u);
            asm volatile("s_waitcnt vmcnt(0)" ::: "memory");
        } else {
            XB_SPIN(xb_ld(&bar[XB_XGEN(b.x)]) == gen, bar);
            __builtin_amdgcn_fence(__ATOMIC_ACQUIRE, "agent");
            asm volatile("s_waitcnt vmcnt(0)" ::: "memory");
        }
    }
    __syncthreads();
}
constexpr int NWAVES = 8;
constexpr int DM = 1024, NCTX = 8192, NLAT = 4096, MTOK = NCTX + NLAT, DIN = 4096, DFF = 2816, NUP = 2 * DFF, NMOD = 6 * DM;
constexpr int ZP = 4096;
constexpr float EPS = 1e-6f;
constexpr int NPH = 8;
constexpr size_t MiB = 1u << 20;
constexpr size_t WS_CTL = 0, CTL_ZERO_BYTES = 1 * MiB;
constexpr size_t WS_ROWSS = 128 * 1024;
constexpr size_t WS_BUP = 256 * 1024;
constexpr size_t WS_MOD = 512 * 1024;
constexpr size_t WS_WIN = 1 * MiB, WS_WP = 9 * MiB, WS_WN = 10 * MiB, WS_WO = 11 * MiB, WS_WUP = 13 * MiB, WS_WD = 24 * MiB, WS_WPOOL = 30 * MiB;
constexpr size_t WS_CK = 30 * MiB + 512 * 1024, WS_CV = 31 * MiB + 512 * 1024;
constexpr size_t WS_XN = 33 * MiB;
constexpr size_t WS_Z = 57 * MiB;
constexpr size_t WS_U = 57 * MiB;
constexpr size_t WS_NA = 189 * MiB, WS_MIX = 201 * MiB, WS_MB = 213 * MiB;
constexpr size_t WS_ACT = 189 * MiB;
constexpr size_t WS_END = 256 * MiB;
static_assert(WS_U + (size_t)MTOK * NUP * 2 <= WS_NA && WS_ACT + (size_t)MTOK * DFF * 2 <= WS_END && WS_MB + (size_t)MTOK * DM * 2 <= WS_END, "ws map");
constexpr int CW_BAR = 4096;
constexpr int RING_OFF = 0, RING_BYTES = 131072;
constexpr int LDSCTL_OFF = RING_BYTES, MISC_OFF = LDSCTL_OFF + 320;
constexpr int LDS_BYTES = 147456;

#define LAS __attribute__((address_space(3)))
typedef unsigned short bf16;
typedef unsigned v4u __attribute__((ext_vector_type(4)));
typedef unsigned v2u __attribute__((ext_vector_type(2)));
typedef float f32x4 __attribute__((ext_vector_type(4)));
typedef float f32x16 __attribute__((ext_vector_type(16)));
typedef short bf16x8 __attribute__((ext_vector_type(8)));
typedef short s16x4 __attribute__((ext_vector_type(4)));
#define LDS_WAIT() asm volatile("s_waitcnt lgkmcnt(0)" ::: "memory")
using pg8::cvt_pk_bf16; using pg8::bf_lo; using pg8::bf_hi;

struct Args { const float* in[23]; float* out; unsigned char* ws; int ph_lo, ph_hi; };

__device__ __forceinline__ float wave_sum(float v) {
#pragma unroll
    for (int o = 1; o < 64; o <<= 1) v += __shfl_xor(v, o);
    return v;
}
__device__ __forceinline__ float siluf_(float x) { return x * __builtin_amdgcn_rcpf(1.0f + __builtin_amdgcn_exp2f(-1.4426950408889634f * x)); }

struct TrItem { const float* W; bf16* WT; int K, N, k0, n0, drow, bup; };
__device__ __forceinline__ void tr_load(const TrItem& t, int lane, f32x4 (&tv)[8]) {
#pragma unroll
    for (int i = 0; i < 8; ++i) tv[i] = *(const f32x4*)(t.W + (size_t)(t.k0 + (lane >> 3) + 8 * i) * t.N + t.n0 + 4 * (lane & 7));
}
__device__ __forceinline__ void tr_store(const TrItem& t, LAS float* scr, int lane, const f32x4 (&tv)[8]) {
#pragma unroll
    for (int i = 0; i < 8; ++i) { LAS float* p = scr + ((lane >> 3) + 8 * i) * 33 + 4 * (lane & 7); p[0] = tv[i][0]; p[1] = tv[i][1]; p[2] = tv[i][2]; p[3] = tv[i][3]; }
    LDS_WAIT(); asm volatile("" ::: "memory");
    const int c = lane & 7;
#pragma unroll
    for (int j = 0; j < 4; ++j) { const int n = (lane >> 3) + 8 * j; const LAS float* s_ = scr + (8 * c) * 33 + n;
        v4u o; o.x = cvt_pk_bf16(s_[0 * 33], s_[1 * 33]); o.y = cvt_pk_bf16(s_[2 * 33], s_[3 * 33]); o.z = cvt_pk_bf16(s_[4 * 33], s_[5 * 33]); o.w = cvt_pk_bf16(s_[6 * 33], s_[7 * 33]);
        *(v4u*)(t.WT + (size_t)(t.drow + n) * t.K + t.k0 + 8 * c) = o; }
    LDS_WAIT(); asm volatile("" ::: "memory");
}
__device__ __forceinline__ void tr_bup(const TrItem& t, const float* MOD, float* BUP, int lane, const f32x4 (&tv)[8]) {
    f32x4 b0 = {0.f, 0.f, 0.f, 0.f}, b1 = b0, b2 = b0;
#pragma unroll
    for (int i = 0; i < 8; ++i) { const int k = t.k0 + (lane >> 3) + 8 * i; b0 += tv[i] * MOD[3 * DM + k]; b1 += tv[i] * MOD[NMOD + 3 * DM + k]; b2 += tv[i] * MOD[2 * NMOD + 3 * DM + k]; }
#pragma unroll
    for (int o = 8; o < 64; o <<= 1)
#pragma unroll
        for (int e = 0; e < 4; ++e) { b0[e] += __shfl_xor(b0[e], o); b1[e] += __shfl_xor(b1[e], o); b2[e] += __shfl_xor(b2[e], o); }
    if (lane < 8) { float* p = BUP + t.n0 + 4 * lane;
#pragma unroll
        for (int e = 0; e < 4; ++e) { atomicAdd(p + e, b0[e]); atomicAdd(p + NUP + e, b1[e]); atomicAdd(p + 2 * NUP + e, b2[e]); } }
}
__device__ __forceinline__ void p0_gemv(const Args& a, int gw, int NGW, int wave, int lane) {
    unsigned char* ws = a.ws;
    float* MOD = (float*)(ws + WS_MOD);
    const int gwT = wave * (NGW >> 3) + (gw >> 3);
    for (int t = gwT; t < 96 * 16; t += NGW) {
        const int cg = t % 96, ks = t / 96, col = cg * 64 + lane, k0 = ks * 64;
        const float s0 = siluf_(a.in[5][k0 + lane]), s1 = siluf_(a.in[4][k0 + lane]), s2 = siluf_(a.in[4][1024 + k0 + lane]);
        float a0 = 0.f, a1 = 0.f, a2 = 0.f;
        const float* wp = a.in[8] + (size_t)k0 * NMOD + col;
#pragma unroll
        for (int kh = 0; kh < 64; kh += 32) { float wv[32];
#pragma unroll
            for (int kk = 0; kk < 32; ++kk) wv[kk] = wp[(size_t)(kh + kk) * NMOD];
#pragma unroll
            for (int kk = 0; kk < 32; ++kk) { a0 += __shfl(s0, kh + kk) * wv[kk]; a1 += __shfl(s1, kh + kk) * wv[kk]; a2 += __shfl(s2, kh + kk) * wv[kk]; } }
        if (ks == 0) { const float b = a.in[9][col]; a0 += b; a1 += b; a2 += b; }
        atomicAdd(MOD + col, a0); atomicAdd(MOD + NMOD + col, a1); atomicAdd(MOD + 2 * NMOD + col, a2);
    }
}
__device__ __forceinline__ void p1_convert(const Args& a, LAS unsigned char* lds, int gw, int NGW, int wave, int lane) {
    unsigned char* ws = a.ws;
    LAS float* scr = (LAS float*)(lds + RING_OFF + wave * 16384);
    const int gwT = wave * (NGW >> 3) + (gw >> 3);
    for (int ft = gwT; ft < 512; ft += NGW) {
        const int g = ft >> 7, k0 = (ft & 127) * 8;
        float wi[8][2];
#pragma unroll
        for (int j = 0; j < 8; ++j) { const float* wr_ = a.in[10] + (size_t)(k0 + j) * 4096 + g * 128 + lane; wi[j][0] = wr_[0]; wi[j][1] = wr_[64]; }
        float ac[8][2];
#pragma unroll
        for (int j = 0; j < 8; ++j) { ac[j][0] = 0.f; ac[j][1] = 0.f; }
        const float* pw = a.in[13] + (size_t)g * 128 * 128 + 2 * lane;
#pragma unroll
        for (int hf = 0; hf < 2; ++hf) {
#pragma unroll 16
            for (int c = 0; c < 64; ++c) { const float2 w2 = *(const float2*)(pw + (size_t)(hf * 64 + c) * 128);
#pragma unroll
                for (int j = 0; j < 8; ++j) { const float wv = __int_as_float(__builtin_amdgcn_readlane(__float_as_int(wi[j][hf]), c)); ac[j][0] += wv * w2.x; ac[j][1] += wv * w2.y; } } }
        const float2 sp = *(const float2*)(a.in[14] + g * 128 + 2 * lane);
        bf16* wt = (bf16*)(ws + WS_WIN) + (size_t)(g * 128 + 2 * lane) * 1024 + k0;
        v4u o; o.x = cvt_pk_bf16(ac[0][0] * sp.x, ac[1][0] * sp.x); o.y = cvt_pk_bf16(ac[2][0] * sp.x, ac[3][0] * sp.x); o.z = cvt_pk_bf16(ac[4][0] * sp.x, ac[5][0] * sp.x); o.w = cvt_pk_bf16(ac[6][0] * sp.x, ac[7][0] * sp.x);
        *(v4u*)wt = o;
        o.x = cvt_pk_bf16(ac[0][1] * sp.y, ac[1][1] * sp.y); o.y = cvt_pk_bf16(ac[2][1] * sp.y, ac[3][1] * sp.y); o.z = cvt_pk_bf16(ac[4][1] * sp.y, ac[5][1] * sp.y); o.w = cvt_pk_bf16(ac[6][1] * sp.y, ac[7][1] * sp.y);
        *(v4u*)(wt + 1024) = o;
    }
    constexpr int I_IN = 16 * 112, I_P = 8 * 32, NITEMS = I_IN + 2 * I_P;
#define P1_DECODE(T, it_) do { int r = (it_); \
        if (r < I_IN) { const int kb = r / 112, nb = 16 + r % 112, n0 = nb * 32, pn = n0 >> 8, lc = n0 & 255;   \
            T = TrItem{a.in[10], (bf16*)(ws + WS_WIN), 1024, 4096, kb * 64, n0, (pn >= 2 && pn < 8) ? 256 * pn + 128 * ((lc & 63) >> 5) + 32 * (lc >> 6) : n0, 0}; } \
        else { r -= I_IN; const int w_ = r >= I_P; r -= w_ * I_P; const int kb = r / 32, nb = r % 32; T = TrItem{a.in[16 + w_], (bf16*)(ws + (w_ ? WS_WN : WS_WP)), 512, 1024, kb * 64, nb * 32, nb * 32, 0}; } } while (0)
    for (int it = NGW - 1 - gw; it < NITEMS; it += 2 * NGW) {
        TrItem A, B; f32x4 ta[8], tb[8]; const bool hasB = it + NGW < NITEMS;
        P1_DECODE(A, it); tr_load(A, lane, ta);
        if (hasB) { P1_DECODE(B, it + NGW); tr_load(B, lane, tb); }
        tr_store(A, scr, lane, ta);
        if (hasB) tr_store(B, scr, lane, tb);
    }
#undef P1_DECODE
    for (int i = gw * 64 + lane; i < 2 * 65536; i += NGW * 64) {
        const int t = i >> 16, e = (i & 65535) * 8; const float* src = a.in[2 + t] + e;
        const f32x4 x0 = *(const f32x4*)src, x1 = *(const f32x4*)(src + 4);
        v4u o; o.x = cvt_pk_bf16(x0[0], x0[1]); o.y = cvt_pk_bf16(x0[2], x0[3]); o.z = cvt_pk_bf16(x1[0], x1[1]); o.w = cvt_pk_bf16(x1[2], x1[3]);
        *(v4u*)((bf16*)(ws + (t ? WS_CV : WS_CK)) + e) = o;
    }
}

constexpr int H_O = 16 * 32, H_UP = 16 * 176, H_D = 44 * 32, HITEMS = H_O + H_UP + H_D, HSPLIT = 2560;
__device__ __forceinline__ void late_items(const Args& a, LAS unsigned char* lds, int lo, int hi, int hw, int NHW, int wave, int lane) {
    LAS float* scr = (LAS float*)(lds + RING_OFF + wave * 16384);
    const float* MOD = (const float*)(a.ws + WS_MOD); float* BUP = (float*)(a.ws + WS_BUP);
#define H_DECODE(T, it_) do { int r = (it_); \
        if (r < H_O) { const int kb = r / 32, nb = r % 32; T = TrItem{a.in[18], (bf16*)(a.ws + WS_WO), 1024, 1024, kb * 64, nb * 32, nb * 32, 0}; } \
        else if (r < H_O + H_UP) { r -= H_O; const int kb = r / 176, nb = r % 176, n0 = nb * 32;   \
            T = TrItem{a.in[19], (bf16*)(a.ws + WS_WUP), 1024, NUP, kb * 64, n0, n0 < DFF ? 256 * (n0 / 128) + (n0 % 128) : 256 * ((n0 - DFF) / 128) + 128 + ((n0 - DFF) % 128), 1}; } \
        else { r -= H_O + H_UP; const int kb = r / 32, nb = r % 32; T = TrItem{a.in[22], (bf16*)(a.ws + WS_WD), DFF, 1024, kb * 64, nb * 32, nb * 32, 0}; } } while (0)
    for (int it = lo + hw; it < hi; it += 2 * NHW) {
        TrItem A, B; f32x4 ta[8], tb[8]; const bool hasB = it + NHW < hi;
        H_DECODE(A, it); tr_load(A, lane, ta);
        if (hasB) { H_DECODE(B, it + NHW); tr_load(B, lane, tb); }
        if (A.bup) tr_bup(A, MOD, BUP, lane, ta);
        tr_store(A, scr, lane, ta);
        if (hasB) { if (B.bup) tr_bup(B, MOD, BUP, lane, tb); tr_store(B, scr, lane, tb); }
    }
#undef H_DECODE
}
template <int R> __device__ __forceinline__ void modnorm_rows(const float* x0, const float* x1, bf16* XNo, const float* g, const float* MODp, int sh, int m0, int stride, int lane) {
    f32x4 v[R][4]; float ss[R];
#pragma unroll
    for (int i = 0; i < R; ++i) { const int m = m0 + i * stride, mc = m < MTOK ? m : m0; const float* xr = mc < NCTX ? x0 + (size_t)mc * DM : x1 + (size_t)(mc - NCTX) * DM;
#pragma unroll
        for (int j = 0; j < 4; ++j) v[i][j] = *(const f32x4*)(xr + 256 * j + 4 * lane); }
#pragma unroll
    for (int i = 0; i < R; ++i) { float s = 0.f;
#pragma unroll
        for (int j = 0; j < 4; ++j) s += (v[i][j][0] * v[i][j][0] + v[i][j][1] * v[i][j][1]) + (v[i][j][2] * v[i][j][2] + v[i][j][3] * v[i][j][3]);
        ss[i] = s; }
#pragma unroll
    for (int o = 1; o < 64; o <<= 1) {
#pragma unroll
        for (int i = 0; i < R; ++i) ss[i] += __shfl_xor(ss[i], o); }
#pragma unroll
    for (int i = 0; i < R; ++i) { const int m = m0 + i * stride; if (m < MTOK) {
        const float rstd = 1.0f / sqrtf(ss[i] * (1.f / DM) + EPS); const float* modv = MODp + (m < NCTX ? 0 : 1 + ((m - NCTX) >> 11)) * NMOD;
#pragma unroll
        for (int j = 0; j < 4; ++j) { const int c = 256 * j + 4 * lane;
            const f32x4 gg = *(const f32x4*)(g + c), shf = *(const f32x4*)(modv + sh * 1024 + c), scl = *(const f32x4*)(modv + (sh + 1) * 1024 + c);
            const f32x4 y = v[i][j] * rstd * gg * (scl + 1.0f) + shf;
            v2u o; o.x = cvt_pk_bf16(y[0], y[1]); o.y = cvt_pk_bf16(y[2], y[3]);
            *(v2u*)(XNo + (size_t)m * DM + c) = o; } } }
}


typedef short v4i16_t __attribute__((ext_vector_type(4)));
__device__ __forceinline__ s16x4 vtr(const LAS unsigned char* p) { return __builtin_bit_cast(s16x4, __builtin_amdgcn_ds_read_tr16_b64_v4i16((LAS v4i16_t*)p)); }
constexpr int VS = 144;
constexpr float NEGBIG = -1e30f;
__device__ __forceinline__ int clampi(int x, int lo, int hi) { return x < lo ? lo : (x > hi ? hi : x); }

__device__ __forceinline__ void attn_task(const Args& a, LAS unsigned char* vl, bool latent, int id, int lane) {
    const bf16* Z = (const bf16*)(a.ws + WS_Z);
    const bf16* CK = (const bf16*)(a.ws + WS_CK); const bf16* CV = (const bf16*)(a.ws + WS_CV);
    bf16* NA = (bf16*)(a.ws + WS_NA);
    const int r32 = lane & 31, hi = lane >> 5;
    int b, h, qtok, nblk, qrow = 0, qcol = 0, rlo = 0, bs = 0;
    if (!latent) { const int qb = id & 7; h = (id >> 3) & 7; b = id >> 6; qtok = b * 256 + qb * 32 + r32; nblk = 8; }
    else { const int nq = id & 3, rp = (id >> 2) & 15; h = (id >> 6) & 7; b = id >> 9; qrow = 2 * rp + (r32 >> 4); qcol = 16 * nq + (r32 & 15); qtok = NCTX + b * 2048 + qrow * 64 + qcol;
        rlo = clampi(2 * rp - 4, 0, 24); const int rhi = clampi(2 * rp - 3, 0, 24) + 7; bs = clampi(16 * nq - 8, 0, 32); nblk = 16 + (rhi - rlo + 1); }
    const int rs_q = clampi(qrow - 4, 0, 24), ws_q = clampi(qcol - 8, 0, 48);
    constexpr float L2E = 1.4426950408889634f;
    LAS float* tab = (LAS float*)(vl + 9216);
    if (latent) { const float* rpb = a.in[15] + h * (15 * 31);
#pragma unroll
        for (int i = 0; i < 8; ++i) { const int e = i * 64 + lane; tab[e] = e < 465 ? rpb[e] * L2E : 0.f; } }
    unsigned okc = 0u;
#pragma unroll
    for (int i = 0; i < 16; ++i) { const int kc = bs + (i & 3) + 8 * (i >> 2) + 4 * hi; okc |= ((kc >= ws_q) && (kc < ws_q + 16)) ? (1u << i) : 0u; }
    const int dcb = bs + 4 * hi - qcol + 15;
    bf16x8 qf[4];
#pragma unroll
    for (int s = 0; s < 4; ++s) qf[s] = *(const bf16x8*)(Z + (size_t)qtok * ZP + 512 + h * 64 + 16 * s + 8 * hi);
    constexpr float ATT_THR = 8.0f;
    float mrun = 0.f, lrun = 0.f;
    f32x16 negm = {};
    f32x16 o0 = {}, o1 = {};
    v4u kA[4], kB[4]; v4u vA[4], vB[4];
#define ATT_LOAD(KS, VS_, t) do { const bf16* kp_; const bf16* vp_; int pitch_; \
        if (latent && (t) < 16) { const size_t o_ = ((size_t)(b * 8 + h) * 512 + 32 * (t)) * 64; kp_ = CK + o_; vp_ = CV + o_; pitch_ = 64; } \
        else { const int tok_ = latent ? NCTX + b * 2048 + (rlo + (t) - 16) * 64 + bs : b * 256 + 32 * (t); kp_ = Z + (size_t)tok_ * ZP + 1024 + h * 64; vp_ = kp_ + 512; pitch_ = ZP; } \
        _Pragma("unroll") for (int i = 0; i < 4; ++i) { const int c_ = i * 64 + lane; KS[i] = *(const v4u*)(kp_ + (size_t)(c_ >> 3) * pitch_ + (c_ & 7) * 8); VS_[i] = *(const v4u*)(vp_ + (size_t)(c_ >> 3) * pitch_ + (c_ & 7) * 8); } } while (0)
    const int li = lane & 15;
    const LAS unsigned char* vrd = vl + (4 * hi + (li >> 2)) * VS + (16 * ((lane >> 4) & 1) + 4 * (li & 3)) * 2;
#define ATT_BLOCK(KS, VS_, t, tn, DO_LOAD) do { \
        _Pragma("unroll") for (int i = 0; i < 4; ++i) { const int c_ = i * 64 + lane; *(LAS v4u*)(vl + (c_ >> 3) * VS + (c_ & 7) * 16) = VS_[i]; *(LAS v4u*)(vl + 4608 + (c_ >> 3) * VS + (c_ & 7) * 16) = KS[i]; } \
        bf16x8 kf_[4]; \
        _Pragma("unroll") for (int k = 0; k < 4; ++k) kf_[k] = *(const LAS bf16x8*)(vl + 4608 + r32 * VS + 32 * k + 16 * hi); \
        f32x16 s = negm;                                     \
        _Pragma("unroll") for (int k = 0; k < 4; ++k) s = __builtin_amdgcn_mfma_f32_32x32x16_bf16(kf_[k], qf[k], s, 0, 0, 0); \
        asm volatile("" ::: "memory"); \
        if (DO_LOAD) ATT_LOAD(KS, VS_, (tn)); \
        const bool loc = latent && (t) >= 16; \
        float x[16]; float bm = NEGBIG; \
        if (loc) { const int kr = rlo + (t) - 16; const bool okr = (kr >= rs_q) && (kr < rs_q + 8); \
            const LAS float* tb = tab + (kr - qrow + 7) * 31 + dcb; \
            _Pragma("unroll") for (int i = 0; i < 16; ++i) { const float bias = tb[(i & 3) + 8 * (i >> 2)]; \
                const float v = (okr && ((okc >> i) & 1u)) ? s[i] + bias : NEGBIG; x[i] = v; bm = fmaxf(bm, v); } } \
        else { _Pragma("unroll") for (int i = 0; i < 16; ++i) { x[i] = s[i]; bm = fmaxf(bm, s[i]); } } \
        bm = fmaxf(bm, __shfl_xor(bm, 32)); \
        if ((t) == 0 || __any(bm > ATT_THR)) {                  \
            const float d = (t) == 0 ? bm : fmaxf(bm, 0.f), alpha = (t) == 0 ? 1.0f : __builtin_amdgcn_exp2f(-d); \
            mrun += d; lrun *= alpha; \
            _Pragma("unroll") for (int i = 0; i < 16; ++i) { x[i] -= d; o0[i] *= alpha; o1[i] *= alpha; negm[i] = -mrun; } } \
        float ps = 0.f; \
        _Pragma("unroll") for (int i = 0; i < 16; ++i) { x[i] = __builtin_amdgcn_exp2f(x[i]); ps += x[i]; } \
        lrun += ps; \
        bf16x8 pf[2]; \
        _Pragma("unroll") for (int sp = 0; sp < 2; ++sp) { v4u w; w.x = cvt_pk_bf16(x[8 * sp + 0], x[8 * sp + 1]); w.y = cvt_pk_bf16(x[8 * sp + 2], x[8 * sp + 3]); w.z = cvt_pk_bf16(x[8 * sp + 4], x[8 * sp + 5]); w.w = cvt_pk_bf16(x[8 * sp + 6], x[8 * sp + 7]); pf[sp] = __builtin_bit_cast(bf16x8, w); } \
        _Pragma("unroll") for (int sp = 0; sp < 2; ++sp) { \
            const s16x4 l0 = vtr(vrd + (16 * sp) * VS), h0 = vtr(vrd + (16 * sp + 8) * VS), l1 = vtr(vrd + (16 * sp) * VS + 64), h1 = vtr(vrd + (16 * sp + 8) * VS + 64); \
            const bf16x8 v0 = (bf16x8){l0[0], l0[1], l0[2], l0[3], h0[0], h0[1], h0[2], h0[3]}, v1 = (bf16x8){l1[0], l1[1], l1[2], l1[3], h1[0], h1[1], h1[2], h1[3]}; \
            o0 = __builtin_amdgcn_mfma_f32_32x32x16_bf16(v0, pf[sp], o0, 0, 0, 0); \
            o1 = __builtin_amdgcn_mfma_f32_32x32x16_bf16(v1, pf[sp], o1, 0, 0, 0); } \
        asm volatile("" ::: "memory"); } while (0)
    ATT_LOAD(kA, vA, 0); ATT_LOAD(kB, vB, 1);
    const int npair = nblk >> 1, lastb = nblk - 1;
#define ATT_PAIR(t_) do { const int t = (t_); ATT_BLOCK(kA, vA, t, (t + 2 < lastb ? t + 2 : lastb), true); ATT_BLOCK(kB, vB, t + 1, (t + 3 < lastb ? t + 3 : lastb), true); } while (0)
    int p = 0;
    for (; p < npair; ++p) ATT_PAIR(2 * p);
#undef ATT_PAIR
    if (nblk & 1) ATT_BLOCK(kA, vA, lastb, lastb, false);
#undef ATT_LOAD
#undef ATT_BLOCK
    const float inv = 1.0f / (lrun + __shfl_xor(lrun, 32));
    const int otok = latent ? qtok : (qtok & ~255) + 2 * (qtok & 127) + ((qtok >> 7) & 1);
    bf16* op = NA + (size_t)otok * 512 + h * 64 + 4 * hi;
#pragma unroll
    for (int g = 0; g < 4; ++g) {
        v2u w0; w0.x = cvt_pk_bf16(o0[4 * g] * inv, o0[4 * g + 1] * inv); w0.y = cvt_pk_bf16(o0[4 * g + 2] * inv, o0[4 * g + 3] * inv);
        v2u w1; w1.x = cvt_pk_bf16(o1[4 * g] * inv, o1[4 * g + 1] * inv); w1.y = cvt_pk_bf16(o1[4 * g + 2] * inv, o1[4 * g + 3] * inv);
        *(v2u*)(op + 8 * g) = w0; *(v2u*)(op + 32 + 8 * g) = w1;
    }
}

template <int GI> struct PoolQuad { v4u w[2 << GI]; };
template <int GI> __device__ __forceinline__ void pool_load(const Args& a, int tq, int lane, PoolQuad<GI>& q) {
    const bf16* Z = (const bf16*)(a.ws + WS_Z);
    constexpr int half = 1 << GI;
    const int tok = 4 * tq + (lane >> 4), col = GI * 128 + 8 * (lane & 15);
    const int L = tok < NCTX ? 256 : 2048, s0 = tok < NCTX ? (tok & ~255) : NCTX + ((tok - NCTX) & ~2047), tpos = tok - s0;
#pragma unroll
    for (int o = 0; o < 2 * half; ++o) { const int tp = tpos - half + o; const int tpc = (tp >= 0 && tp < L) ? tp : tpos; q.w[o] = *(const v4u*)(Z + col + (size_t)(s0 + tpc) * ZP); }
}
template <int GI> __device__ __forceinline__ void pool_finish(const Args& a, int tq, int lane, const PoolQuad<GI>& q) {
    bf16* MIX = (bf16*)(a.ws + WS_MIX);
    constexpr int half = 1 << GI;
    const int tok = 4 * tq + (lane >> 4), col = GI * 128 + 8 * (lane & 15);
    const int L = tok < NCTX ? 256 : 2048, s0 = tok < NCTX ? (tok & ~255) : NCTX + ((tok - NCTX) & ~2047), tpos = tok - s0;
    const int lo = tpos - half < 0 ? 0 : tpos - half, hi = tpos + half > L ? L : tpos + half;
    const float rc = 1.0f / (float)(hi - lo);
    float sum[8];
#pragma unroll
    for (int e = 0; e < 8; ++e) sum[e] = 0.f;
#pragma unroll
    for (int o = 0; o < 2 * half; ++o) { const int tp = tpos - half + o; const float mk = (tp >= 0 && tp < L) ? 1.f : 0.f;
        sum[0] += mk * bf_lo(q.w[o].x); sum[1] += mk * bf_hi(q.w[o].x); sum[2] += mk * bf_lo(q.w[o].y); sum[3] += mk * bf_hi(q.w[o].y);
        sum[4] += mk * bf_lo(q.w[o].z); sum[5] += mk * bf_hi(q.w[o].z); sum[6] += mk * bf_lo(q.w[o].w); sum[7] += mk * bf_hi(q.w[o].w); }
    const v4u c = q.w[half];
    v4u p; p.x = cvt_pk_bf16(sum[0] * rc - bf_lo(c.x), sum[1] * rc - bf_hi(c.x)); p.y = cvt_pk_bf16(sum[2] * rc - bf_lo(c.y), sum[3] * rc - bf_hi(c.y));
    p.z = cvt_pk_bf16(sum[4] * rc - bf_lo(c.z), sum[5] * rc - bf_hi(c.z)); p.w = cvt_pk_bf16(sum[6] * rc - bf_lo(c.w), sum[7] * rc - bf_hi(c.w));
    *(v4u*)(MIX + (size_t)tok * 512 + col) = p;
}
template <int GI> __device__ __forceinline__ void pool_run3(const Args& a, int tq0, int lane) {
    PoolQuad<GI> qa, qb;
    pool_load<GI>(a, tq0, lane, qa); pool_load<GI>(a, tq0 + 1, lane, qb);
    asm volatile("" ::: "memory");
    pool_finish<GI>(a, tq0, lane, qa);
    pool_load<GI>(a, tq0 + 2, lane, qa);
    asm volatile("" ::: "memory");
    pool_finish<GI>(a, tq0 + 1, lane, qb);
    pool_finish<GI>(a, tq0 + 2, lane, qa);
}

__global__ void __launch_bounds__(NWAVES * 64, 2) fwd_kernel(Args args) {
    extern __shared__ __attribute__((aligned(16))) unsigned char lds_raw[];
    LAS unsigned char* lds = (LAS unsigned char*)lds_raw;
    volatile LAS unsigned* MISC = (volatile LAS unsigned*)(lds + MISC_OFF);
    const int tid = threadIdx.x, lane = tid & 63, wave = __builtin_amdgcn_readfirstlane(tid >> 6);
    const int G = gridDim.x, bx = blockIdx.x, vcu = (G % 8 == 0) ? (bx % 8) * (G / 8) + bx / 8 : bx;
    const int gw = vcu * NWAVES + wave, NGW = G * NWAVES;
    unsigned char* ws = args.ws;
    for (int u = tid; u < (LDS_BYTES - LDSCTL_OFF) / 4; u += NWAVES * 64) ((LAS unsigned*)(lds + LDSCTL_OFF))[u] = 0u;
    __syncthreads();
#if MK_PER_PHASE
#define GRID_BAR() do { } while (0)
#else
    XcdBarrier bar = xcd_barrier_post((unsigned*)(ws + WS_CTL) + CW_BAR, MISC + 8);
#define GRID_BAR() xcd_barrier(bar)
#endif
    const int lo = args.ph_lo, hi = args.ph_hi;
#define IN(k) (lo <= (k) && (k) < hi)
#define SEAM(k) do { if (IN(k) && IN((k) + 1)) GRID_BAR(); } while (0)
    const float* MOD = (const float*)(ws + WS_MOD);
    bf16* XN = (bf16*)(ws + WS_XN); bf16* Zb = (bf16*)(ws + WS_Z);
    float* Y = args.out;

    if (IN(0)) { p0_gemv(args, gw, NGW, wave, lane); } SEAM(0);
    if (IN(1)) {
        p1_convert(args, lds, gw, NGW, wave, lane);
        for (int m0 = gw; m0 < MTOK; m0 += 6 * NGW) modnorm_rows<6>(args.in[0], args.in[1], XN, args.in[6], MOD, 0, m0, NGW, lane); } SEAM(1);
    if (IN(2)) { pg8::Gemm g{XN, (const bf16*)(ws + WS_WIN), MTOK, DIN, DM}; pg8::StaticOrder S; S.init(MTOK, DIN, G, bx);
        pg8::EpiQKV E{Zb, args.in[11], args.in[12], Y + (size_t)MTOK * DM, Y + (size_t)MTOK * DM + (size_t)NCTX * 512}; pg8::gemm_phase<pg8::EpiQKV, pg8::StaticOrder, true, true>(lds + RING_OFF, g, S, E); } SEAM(2);
    if (IN(3)) {
        LAS unsigned char* vl = lds + RING_OFF + wave * 16384;
        if (wave < 4) { for (int id = vcu * 4 + wave; id < 1024; id += G * 4) attn_task(args, vl, true, id, lane); }
        else { for (int id = vcu * 4 + (wave - 4); id < 1024; id += G * 4) { attn_task(args, vl, false, 2 * id, lane); attn_task(args, vl, false, 2 * id + 1, lane); } }
        for (int tb = vcu * 12; tb < MTOK / 4; tb += G * 12) { const int tq0 = tb + 3 * (wave & 3);
            if (wave < 4) { pool_run3<0>(args, tq0, lane); pool_run3<1>(args, tq0, lane); } else { pool_run3<2>(args, tq0, lane); pool_run3<3>(args, tq0, lane); } }
    } SEAM(3);
    const bool helper = G > 192 ? bx >= 192 : true; const int NHW = (G > 192 ? G - 192 : G) * NWAVES, hw = (G > 192 ? bx - 192 : bx) * NWAVES + wave;
    if (IN(4)) { bf16* T1 = XN;
        if (helper) late_items(args, lds, 0, HSPLIT, hw, NHW, wave, lane);
        { pg8::Gemm g{(const bf16*)(ws + WS_MIX), (const bf16*)(ws + WS_WP), MTOK, DM, 512}; pg8::StaticOrder S; S.init(MTOK, DM, G, bx);
          pg8::EpiStoreBf16 E{T1, DM}; pg8::gemm_phase<pg8::EpiStoreBf16, pg8::StaticOrder, true, true>(lds + RING_OFF, g, S, E); }
        asm volatile("s_waitcnt vmcnt(0)" ::: "memory"); __syncthreads();
        { pg8::Gemm g{(const bf16*)(ws + WS_NA), (const bf16*)(ws + WS_WN), MTOK, DM, 512}; pg8::StaticOrder S; S.init(MTOK, DM, G, bx);
          pg8::EpiMerge E{T1, Zb, (bf16*)(ws + WS_MB)}; pg8::gemm_phase<pg8::EpiMerge, pg8::StaticOrder, true, true>(lds + RING_OFF, g, S, E); }
    } SEAM(4);
    if (IN(5)) { if (helper) late_items(args, lds, HSPLIT, HITEMS, hw, NHW, wave, lane);
        pg8::Gemm g{(const bf16*)(ws + WS_MB), (const bf16*)(ws + WS_WO), MTOK, DM, DM}; pg8::StaticOrder S; S.init(MTOK, DM, G, bx);
        pg8::EpiResidNorm E{args.in[0], args.in[1], Y, MOD + 2 * DM, args.in[7], MOD + 4 * DM, XN, (float*)(ws + WS_ROWSS)}; pg8::gemm_phase<pg8::EpiResidNorm, pg8::StaticOrder, true, true>(lds + RING_OFF, g, S, E); } SEAM(5);
    if (IN(6)) { pg8::Gemm g{XN, (const bf16*)(ws + WS_WUP), 50 * 256, NUP, DM}; pg8::UpOrder S; S.init(50 * 256, NUP, G, bx);
        pg8::EpiConvGate E{(bf16*)(ws + WS_ACT), (const float*)(ws + WS_ROWSS), (const float*)(ws + WS_BUP), args.in[20], args.in[21], (LAS float*)(lds + LDSCTL_OFF + 1024)};
        pg8::gemm_phase<pg8::EpiConvGate, pg8::UpOrder, true, true>(lds + RING_OFF, g, S, E); } SEAM(6);
    if (IN(7)) { pg8::Gemm g{(const bf16*)(ws + WS_ACT), (const bf16*)(ws + WS_WD), MTOK, DM, DFF}; pg8::StaticOrder S; S.init(MTOK, DM, G, bx);
        pg8::EpiResid E{Y, Y + (size_t)NCTX * DM, Y, MOD + 5 * DM}; pg8::gemm_phase<pg8::EpiResid, pg8::StaticOrder, true, true>(lds + RING_OFF, g, S, E); }
#undef IN
#undef SEAM
}

extern "C" void kernel_launch(void* const* d_in, const int* in_sizes, int n_in, void* d_out, int out_size, void* d_ws, size_t ws_size, hipStream_t stream) {
    static int grid = 0;
    if (grid == 0) {
        if (n_in != 23 || ws_size < WS_END) { fprintf(stderr, "kernel_launch: unexpected n_in %d / ws %zu\n", n_in, ws_size); grid = -1; return; }
        int dev = 0, cus = 0, per_cu = 0;
        if (hipGetDevice(&dev) != hipSuccess || hipDeviceGetAttribute(&cus, hipDeviceAttributeMultiprocessorCount, dev) != hipSuccess) { grid = -1; return; }
        if (hipFuncSetAttribute((const void*)fwd_kernel, hipFuncAttributeMaxDynamicSharedMemorySize, LDS_BYTES) != hipSuccess) { fprintf(stderr, "kernel_launch: hipFuncSetAttribute failed\n"); grid = -1; return; }
        if (hipOccupancyMaxActiveBlocksPerMultiprocessor(&per_cu, (const void*)fwd_kernel, NWAVES * 64, LDS_BYTES) != hipSuccess || per_cu < 1) { fprintf(stderr, "kernel_launch: occupancy query says %d\n", per_cu); (void)hipGetLastError(); grid = -1; return; }
        grid = cus;
        if (grid % 8) grid -= grid % 8;
    }
    if (grid < 0) return;
    (void)hipMemsetAsync((char*)d_ws + WS_CTL, 0, CTL_ZERO_BYTES, stream);
    Args a{};
    for (int i = 0; i < 23; ++i) a.in[i] = (const float*)d_in[i];
    a.out = (float*)d_out; a.ws = (unsigned char*)d_ws;
#if MK_PER_PHASE
    for (int p = 0; p < NPH; ++p) { a.ph_lo = p; a.ph_hi = p + 1; hipLaunchKernelGGL(fwd_kernel, dim3(grid), dim3(NWAVES * 64), LDS_BYTES, stream, a); }
#else
    a.ph_lo = 0; a.ph_hi = NPH;
    hipLaunchKernelGGL(fwd_kernel, dim3(grid), dim3(NWAVES * 64), LDS_BYTES, stream, a);
#endif
}
```

```cpp
#include <hip/hip_runtime.h>
#include <cstdio>
#include <cstdint>
#ifndef MK_PER_PHASE
#define MK_PER_PHASE 0
#endif
namespace pg8 {
#define PG8_LAS __attribute__((address_space(3)))
typedef unsigned short bf16_t;
typedef short bf16x8 __attribute__((ext_vector_type(8)));
typedef float f32x4 __attribute__((ext_vector_type(4)));
typedef unsigned u32x4 __attribute__((ext_vector_type(4)));
constexpr int BM = 256, BK = 64, HALF = 128, HTB = HALF * BK * 2  , STAGE_BYTES = 8 * HTB, NXCD = 8, WGM = 8;

__host__ __device__ __forceinline__ int lds_byte(int r, int c) { const int st = (r >> 4) * 2 + (c >> 5), rr = r & 15, cc = c & 31, ob = rr * 64 + cc * 2; return st * 1024 + (ob ^ (((ob >> 9) & 1) << 5)); }
__host__ __device__ __forceinline__ void stage_rc(int b, int& R, int& C) { const int st = b / 1024, sb = b % 1024, swz = sb ^ (((sb >> 9) & 1) << 5); R = (st >> 1) * 16 + swz / 64; C = (st & 1) * 32 + (swz % 64) / 2; }
__host__ __device__ __forceinline__ int perm32(int rho) { const int n = rho >> 4, i = rho & 15; return 8 * (i >> 2) + 4 * n + (i & 3); }

struct Unit { int pm, pn, arow; };
struct Gemm { const bf16_t* A; const bf16_t* Bt; int M, N, K; };

struct StaticOrder {
    int nM, nN, nwg, G, c;
    __host__ __device__ void init(int M, int N, int G_, int c_) { nM = M / BM; nN = N / BM; nwg = nM * nN; G = G_; c = c_; }
    __host__ __device__ bool next(int i, Unit& u) const {
        const long L = (long)i * G + c; if (L >= nwg) return false;
        int wgid = (int)L; { const int q = nwg / NXCD, r = nwg % NXCD, xcd = wgid % NXCD, off = wgid / NXCD; wgid = (xcd < r ? xcd * (q + 1) : r * (q + 1) + (xcd - r) * q) + off; }
        const int nig = WGM * nN, gid = wgid / nig, fm = gid * WGM, gsz = (nM - fm) < WGM ? (nM - fm) : WGM;
        u.pm = fm + ((wgid % nig) % gsz); u.pn = (wgid % nig) / gsz; u.arow = u.pm * BM; return true;
    }
    __device__ __forceinline__ void a_ready(const Unit&) const {}
    __device__ __forceinline__ void done(const Unit&) const {}
};

typedef float f32x2_t __attribute__((ext_vector_type(2))); typedef __bf16 bf16x2_t __attribute__((ext_vector_type(2)));
__device__ __forceinline__ unsigned cvt_pk_bf16(float lo, float hi) { f32x2_t v = {lo, hi}; bf16x2_t b = __builtin_convertvector(v, bf16x2_t); return __builtin_bit_cast(unsigned, b); }
__device__ __forceinline__ float bf_lo(unsigned w) { return __uint_as_float(w << 16); }
__device__ __forceinline__ float bf_hi(unsigned w) { return __uint_as_float(w & 0xffff0000u); }
__device__ __forceinline__ float sigmoidf_(float x) { return __builtin_amdgcn_rcpf(1.0f + __builtin_amdgcn_exp2f(-1.4426950408889634f * x)); }

struct EpiStoreBf16 {
    static constexpr bool PERM = true, AFTER_DRAIN = false, APERM = false;
    bf16_t* O; int ldc;
    __device__ __forceinline__ void operator()(const f32x4 (&acc)[2][2][4][2], const Unit& u, int wr, int wc, int fr, int fq) const {
        const int row0 = u.pm * BM + wr * 64 + fr, col0 = u.pn * BM + wc * 32 + 8 * fq;
#pragma unroll
        for (int ai = 0; ai < 2; ++ai)
#pragma unroll
            for (int m = 0; m < 4; ++m) { bf16_t* rowp = O + (size_t)(row0 + ai * HALF + m * 16) * ldc + col0;
#pragma unroll
                for (int bj = 0; bj < 2; ++bj) { const f32x4 v0 = acc[ai][bj][m][0], v1 = acc[ai][bj][m][1];
                    u32x4 w; w.x = cvt_pk_bf16(v0[0], v0[1]); w.y = cvt_pk_bf16(v0[2], v0[3]); w.z = cvt_pk_bf16(v1[0], v1[1]); w.w = cvt_pk_bf16(v1[2], v1[3]);
                    *(u32x4*)(rowp + bj * HALF) = w; } }
    }
};
struct EpiMerge {
    static constexpr bool PERM = true, AFTER_DRAIN = false, APERM = false;
    const bf16_t* T1; const bf16_t* Z; bf16_t* O;
    __device__ __forceinline__ void operator()(const f32x4 (&acc)[2][2][4][2], const Unit& u, int wr, int wc, int fr, int fq) const {
        const int row0 = u.pm * BM + wr * 64 + fr, col0 = u.pn * BM + wc * 32 + 8 * fq;
        u32x4 pt[2][2], pp[2][2], pn_[2][2];
#define MG_LOAD(slot, grp) do { const size_t row_ = (size_t)(row0 + ((grp) >> 2) * HALF + ((grp) & 3) * 16); \
            _Pragma("unroll") for (int bj = 0; bj < 2; ++bj) { const int col_ = col0 + bj * HALF; pt[slot][bj] = *(const u32x4*)(T1 + row_ * 1024 + col_); pp[slot][bj] = *(const u32x4*)(Z + row_ * 4096 + 2048 + col_); pn_[slot][bj] = *(const u32x4*)(Z + row_ * 4096 + 3072 + col_); } } while (0)
        MG_LOAD(0, 0); MG_LOAD(1, 1);
#pragma unroll
        for (int grp = 0; grp < 8; ++grp) { const int ai = grp >> 2, m = grp & 3, sl = grp & 1; const size_t row = (size_t)(row0 + ai * HALF + m * 16);
            u32x4 w[2];
#pragma unroll
            for (int bj = 0; bj < 2; ++bj) { const u32x4 t = pt[sl][bj], gp = pp[sl][bj], gn = pn_[sl][bj]; const f32x4 v0 = acc[ai][bj][m][0], v1 = acc[ai][bj][m][1];
                w[bj].x = cvt_pk_bf16(sigmoidf_(bf_lo(gp.x)) * bf_lo(t.x) + sigmoidf_(bf_lo(gn.x)) * v0[0], sigmoidf_(bf_hi(gp.x)) * bf_hi(t.x) + sigmoidf_(bf_hi(gn.x)) * v0[1]);
                w[bj].y = cvt_pk_bf16(sigmoidf_(bf_lo(gp.y)) * bf_lo(t.y) + sigmoidf_(bf_lo(gn.y)) * v0[2], sigmoidf_(bf_hi(gp.y)) * bf_hi(t.y) + sigmoidf_(bf_hi(gn.y)) * v0[3]);
                w[bj].z = cvt_pk_bf16(sigmoidf_(bf_lo(gp.z)) * bf_lo(t.z) + sigmoidf_(bf_lo(gn.z)) * v1[0], sigmoidf_(bf_hi(gp.z)) * bf_hi(t.z) + sigmoidf_(bf_hi(gn.z)) * v1[1]);
                w[bj].w = cvt_pk_bf16(sigmoidf_(bf_lo(gp.w)) * bf_lo(t.w) + sigmoidf_(bf_lo(gn.w)) * v1[2], sigmoidf_(bf_hi(gp.w)) * bf_hi(t.w) + sigmoidf_(bf_hi(gn.w)) * v1[3]); }
            if (grp + 2 < 8) { if (sl == 0) MG_LOAD(0, grp + 2); else MG_LOAD(1, grp + 2); }
            asm volatile("" ::: "memory");
#pragma unroll
            for (int bj = 0; bj < 2; ++bj) *(u32x4*)(O + row * 1024 + col0 + bj * HALF) = w[bj]; }
#undef MG_LOAD
    }
};
struct EpiResid {
    static constexpr bool PERM = false, AFTER_DRAIN = false, APERM = false;
    const float* base0; const float* base1; float* out; const float* gate;
    __device__ __forceinline__ void operator()(const f32x4 (&acc)[2][2][4][2], const Unit& u, int wr, int wc, int fr, int fq) const {
        const int trow = u.pm * BM, row0 = trow + wr * 64 + fr, col0 = u.pn * BM + wc * 32 + 4 * fq;
        const int mi = trow < 8192 ? 0 : 1 + ((trow - 8192) >> 11);
        const float* bp = trow < 8192 ? base0 : base1 - (size_t)8192 * 1024;
        f32x4 g[2][2];
#pragma unroll
        for (int bj = 0; bj < 2; ++bj)
#pragma unroll
            for (int n = 0; n < 2; ++n) g[bj][n] = *(const f32x4*)(gate + mi * 6144 + col0 + bj * HALF + n * 16);
        f32x4 pre[4][2][2];
#define RS_LOAD(slot, grp) do { const size_t off_ = (size_t)(row0 + ((grp) >> 2) * HALF + ((grp) & 3) * 16) * 1024 + col0; \
            _Pragma("unroll") for (int bj = 0; bj < 2; ++bj) _Pragma("unroll") for (int n = 0; n < 2; ++n) pre[slot][bj][n] = *(const f32x4*)(bp + off_ + bj * HALF + n * 16); } while (0)
        RS_LOAD(0, 0); RS_LOAD(1, 1); RS_LOAD(2, 2); RS_LOAD(3, 3);
#pragma unroll
        for (int grp = 0; grp < 8; ++grp) { const int ai = grp >> 2, m = grp & 3, sl = grp & 3; const size_t off = (size_t)(row0 + ai * HALF + m * 16) * 1024 + col0;
            f32x4 r[2][2];
#pragma unroll
            for (int bj = 0; bj < 2; ++bj)
#pragma unroll
                for (int n = 0; n < 2; ++n) r[bj][n] = pre[sl][bj][n] + g[bj][n] * acc[ai][bj][m][n];
            if (grp + 4 < 8) { if (sl == 0) RS_LOAD(0, grp + 4); else if (sl == 1) RS_LOAD(1, grp + 4); else if (sl == 2) RS_LOAD(2, grp + 4); else RS_LOAD(3, grp + 4); }
            asm volatile("" ::: "memory");
#pragma unroll
            for (int bj = 0; bj < 2; ++bj)
#pragma unroll
                for (int n = 0; n < 2; ++n) *(f32x4*)(out + off + bj * HALF + n * 16) = r[bj][n]; }
#undef RS_LOAD
    }
};

__host__ __device__ __forceinline__ int up_arow(int pm) { if (pm < 32) return pm * 256; const int q = pm - 32, seq = q / 9, k = q % 9; int st = 254 * k; if (st > 1792) st = 1792; return 8192 + seq * 2048 + st; }
struct UpOrder : StaticOrder {
    __host__ __device__ bool next(int i, Unit& u) const { if (!StaticOrder::next(i, u)) return false; u.arow = up_arow(u.pm); return true; }
};
__device__ __forceinline__ float siluf__(float x) { return x * __builtin_amdgcn_rcpf(1.0f + __builtin_amdgcn_exp2f(-1.4426950408889634f * x)); }
struct EpiConvGate {
    static constexpr bool PERM = true, AFTER_DRAIN = false, APERM = true;
    bf16_t* ACT; const float* rowss; const float* bup; const float* cw; const float* cb; PG8_LAS float* xch;
    __device__ __forceinline__ void operator()(f32x4 (&acc)[2][2][4][2], const Unit& u, int wr, int wc, int fr, int fq) const {
        const int pm = u.pm; int wlo = 0, whi = 255;
        if (pm >= 32) { const int k = (pm - 32) % 9; if (k == 0) whi = 254; else if (k < 8) { wlo = 1; whi = 254; } else wlo = 241; }
        const int mi = pm < 32 ? 0 : 1 + (pm - 32) / 9;
        const int tok0 = u.arow, cbase = 32 * wc + 8 * fq, ca = 128 * u.pn + cbase;
        f32x4 w0[2], w1[2], w2[2], bb[2];
#pragma unroll
        for (int bj = 0; bj < 2; ++bj) { const int col = bj * 2816 + ca; w0[bj] = *(const f32x4*)(cw + col); w1[bj] = *(const f32x4*)(cw + 5632 + col); w2[bj] = *(const f32x4*)(cw + 2 * 5632 + col); bb[bj] = *(const f32x4*)(cb + col); }
        {   f32x4 rs[2];
#pragma unroll
            for (int ai = 0; ai < 2; ++ai) { const f32x4 ss = *(const f32x4*)(rowss + tok0 + 128 * ai + 64 * wr + 4 * fr);
#pragma unroll
                for (int m = 0; m < 4; ++m) rs[ai][m] = 1.0f / sqrtf(ss[m] * (1.0f / 1024.0f) + 1e-6f); }
#pragma unroll
            for (int bj = 0; bj < 2; ++bj)
#pragma unroll
                for (int n = 0; n < 2; ++n) { const f32x4 b = *(const f32x4*)(bup + mi * 5632 + bj * 2816 + ca + 4 * n);
#pragma unroll
                    for (int ai = 0; ai < 2; ++ai)
#pragma unroll
                        for (int m = 0; m < 4; ++m) acc[ai][bj][m][n] = acc[ai][bj][m][n] * rs[ai][m] + b; } }
        if (fr == 0 || fr == 15) { const int wh = fr == 0 ? 0 : 1;
#pragma unroll
            for (int ai = 0; ai < 2; ++ai)
#pragma unroll
                for (int bj = 0; bj < 2; ++bj)
#pragma unroll
                    for (int n = 0; n < 2; ++n) *(PG8_LAS f32x4*)(xch + ((2 * ai + wr) * 2 + wh) * 256 + 128 * bj + cbase + 4 * n) = fr == 0 ? acc[ai][bj][0][n] : acc[ai][bj][3][n]; }
        asm volatile("s_waitcnt lgkmcnt(0)" ::: "memory"); __builtin_amdgcn_s_barrier(); asm volatile("" ::: "memory");
        const f32x4 zero4 = {0.f, 0.f, 0.f, 0.f};
        typedef unsigned u32x2 __attribute__((ext_vector_type(2)));
#pragma unroll
        for (int n = 0; n < 2; ++n) {
            if (n == 1) {
#pragma unroll
                for (int bj = 0; bj < 2; ++bj) { const int col = bj * 2816 + ca + 4; w0[bj] = *(const f32x4*)(cw + col); w1[bj] = *(const f32x4*)(cw + 5632 + col); w2[bj] = *(const f32x4*)(cw + 2 * 5632 + col); bb[bj] = *(const f32x4*)(cb + col); } }
#pragma unroll
            for (int ai = 0; ai < 2; ++ai) { const int c = 2 * ai + wr;
                f32x4 r[4][2];
#pragma unroll
                for (int bj = 0; bj < 2; ++bj) {
                    const f32x4 P = c > 0 ? *(const PG8_LAS f32x4*)(xch + ((c - 1) * 2 + 1) * 256 + 128 * bj + cbase + 4 * n) : zero4;
                    const f32x4 Nx = c < 3 ? *(const PG8_LAS f32x4*)(xch + ((c + 1) * 2 + 0) * 256 + 128 * bj + cbase + 4 * n) : zero4;
                    const f32x4 c0 = acc[ai][bj][0][n], c1 = acc[ai][bj][1][n], c2 = acc[ai][bj][2][n], c3 = acc[ai][bj][3][n];
                    f32x4 up0, dn3;
#pragma unroll
                    for (int e = 0; e < 4; ++e) { up0[e] = __int_as_float(__builtin_amdgcn_update_dpp(__float_as_int(P[e]), __float_as_int(c3[e]), 0x111, 0xf, 0xf, false));
                        dn3[e] = __int_as_float(__builtin_amdgcn_update_dpp(__float_as_int(Nx[e]), __float_as_int(c0[e]), 0x101, 0xf, 0xf, false)); }
                    r[0][bj] = w0[bj] * up0 + w1[bj] * c0 + w2[bj] * c1 + bb[bj];
                    r[1][bj] = w0[bj] * c0 + w1[bj] * c1 + w2[bj] * c2 + bb[bj];
                    r[2][bj] = w0[bj] * c1 + w1[bj] * c2 + w2[bj] * c3 + bb[bj];
                    r[3][bj] = w0[bj] * c2 + w1[bj] * c3 + w2[bj] * dn3 + bb[bj]; }
#pragma unroll
                for (int m = 0; m < 4; ++m) { const int row = 128 * ai + 64 * wr + 4 * fr + m;
                    u32x2 o; o.x = cvt_pk_bf16(siluf__(r[m][0][0]) * r[m][1][0], siluf__(r[m][0][1]) * r[m][1][1]); o.y = cvt_pk_bf16(siluf__(r[m][0][2]) * r[m][1][2], siluf__(r[m][0][3]) * r[m][1][3]);
                    if (row >= wlo && row <= whi) *(u32x2*)(ACT + (size_t)(tok0 + row) * 2816 + ca + 4 * n) = o; } } }
    }
};
struct EpiResidNorm {
    static constexpr bool PERM = false, AFTER_DRAIN = false, APERM = false;
    const float* base0; const float* base1; float* out; const float* gate; const float* gnorm; const float* scale; bf16_t* XS; float* rowss;
    __device__ __forceinline__ void operator()(const f32x4 (&acc)[2][2][4][2], const Unit& u, int wr, int wc, int fr, int fq) const {
        const int trow = u.pm * BM, row0 = trow + wr * 64 + fr, col0 = u.pn * BM + wc * 32 + 4 * fq;
        const int mi = trow < 8192 ? 0 : 1 + ((trow - 8192) >> 11);
        const float* bp = trow < 8192 ? base0 : base1 - (size_t)8192 * 1024;
        f32x4 g[2][2], gm[2][2];
#pragma unroll
        for (int bj = 0; bj < 2; ++bj)
#pragma unroll
            for (int n = 0; n < 2; ++n) { const int c = col0 + bj * HALF + n * 16; g[bj][n] = *(const f32x4*)(gate + mi * 6144 + c); gm[bj][n] = *(const f32x4*)(gnorm + c) * (*(const f32x4*)(scale + mi * 6144 + c) + 1.0f); }
        f32x4 pre[3][2][2];
#define RN_LOAD(slot, grp) do { const size_t off_ = (size_t)(row0 + ((grp) >> 2) * HALF + ((grp) & 3) * 16) * 1024 + col0; \
            _Pragma("unroll") for (int bj = 0; bj < 2; ++bj) _Pragma("unroll") for (int n = 0; n < 2; ++n) pre[slot][bj][n] = *(const f32x4*)(bp + off_ + bj * HALF + n * 16); } while (0)
        RN_LOAD(0, 0); RN_LOAD(1, 1); RN_LOAD(2, 2);
        typedef unsigned u32x2 __attribute__((ext_vector_type(2)));
#pragma unroll
        for (int grp = 0; grp < 8; ++grp) { const int ai = grp >> 2, m = grp & 3, sl = grp % 3; const size_t off = (size_t)(row0 + ai * HALF + m * 16) * 1024 + col0; float ss = 0.f;
            f32x4 x1[2][2]; u32x2 o[2][2];
#pragma unroll
            for (int bj = 0; bj < 2; ++bj)
#pragma unroll
                for (int n = 0; n < 2; ++n) { x1[bj][n] = pre[sl][bj][n] + g[bj][n] * acc[ai][bj][m][n]; const f32x4 v = x1[bj][n]; ss += (v[0] * v[0] + v[1] * v[1]) + (v[2] * v[2] + v[3] * v[3]);
                    const f32x4 xs = v * gm[bj][n]; o[bj][n].x = cvt_pk_bf16(xs[0], xs[1]); o[bj][n].y = cvt_pk_bf16(xs[2], xs[3]); }
            if (grp + 3 < 8) { if (sl == 0) RN_LOAD(0, grp + 3); else if (sl == 1) RN_LOAD(1, grp + 3); else RN_LOAD(2, grp + 3); }
            asm volatile("" ::: "memory");
#pragma unroll
            for (int bj = 0; bj < 2; ++bj)
#pragma unroll
                for (int n = 0; n < 2; ++n) { *(f32x4*)(out + off + bj * HALF + n * 16) = x1[bj][n]; *(u32x2*)(XS + off + bj * HALF + n * 16) = o[bj][n]; }
            ss += __shfl_xor(ss, 16); ss += __shfl_xor(ss, 32);
            if (fq == 0) atomicAdd(rowss + row0 + ai * HALF + m * 16, ss); }
#undef RN_LOAD
    }
};

struct EpiQKV {
    static constexpr bool PERM = true, AFTER_DRAIN = false, APERM = false;
    bf16_t* Z; const float* qg; const float* kg; float* newk; float* newv;
    __device__ __forceinline__ void operator()(const f32x4 (&acc)[2][2][4][2], const Unit& u, int wr, int wc, int fr, int fq) const {
        const int row0 = u.pm * BM + wr * 64 + fr, pn = u.pn;
        if (pn < 2 || pn >= 8) {
            const int col0 = pn * BM + wc * 32 + 8 * fq;
#pragma unroll
            for (int ai = 0; ai < 2; ++ai)
#pragma unroll
                for (int m = 0; m < 4; ++m) { bf16_t* rowp = Z + (size_t)(row0 + ai * HALF + m * 16) * 4096 + col0;
#pragma unroll
                    for (int bj = 0; bj < 2; ++bj) { const f32x4 v0 = acc[ai][bj][m][0], v1 = acc[ai][bj][m][1];
                        u32x4 w; w.x = cvt_pk_bf16(v0[0], v0[1]); w.y = cvt_pk_bf16(v0[2], v0[3]); w.z = cvt_pk_bf16(v1[0], v1[1]); w.w = cvt_pk_bf16(v1[2], v1[3]);
                        *(u32x4*)(rowp + bj * HALF) = w; } }
            return;
        }
        const int kind = (pn - 2) >> 1, h = 4 * (pn & 1) + wc;
        const int zc = 512 + kind * 512 + h * 64 + 8 * fq;
        const float* gp = kind == 0 ? qg : kg;
        const float qs = kind == 0 ? 0.125f * 1.4426950408889634f : 1.0f;
        f32x4 g0[2], g1[2];
#pragma unroll
        for (int bj = 0; bj < 2; ++bj) { g0[bj] = *(const f32x4*)(gp + 32 * bj + 8 * fq); g1[bj] = *(const f32x4*)(gp + 32 * bj + 8 * fq + 4); }
#pragma unroll
        for (int ai = 0; ai < 2; ++ai)
#pragma unroll
            for (int m = 0; m < 4; ++m) { const int row = row0 + ai * HALF + m * 16;
                f32x4 v[2][2];
#pragma unroll
                for (int bj = 0; bj < 2; ++bj)
#pragma unroll
                    for (int n = 0; n < 2; ++n) v[bj][n] = acc[ai][bj][m][n];
                if (kind < 2) { float ss = 0.f;
#pragma unroll
                    for (int bj = 0; bj < 2; ++bj)
#pragma unroll
                        for (int n = 0; n < 2; ++n) ss += (v[bj][n][0] * v[bj][n][0] + v[bj][n][1] * v[bj][n][1]) + (v[bj][n][2] * v[bj][n][2] + v[bj][n][3] * v[bj][n][3]);
                    ss += __shfl_xor(ss, 16); ss += __shfl_xor(ss, 32);
                    const float rstd = 1.0f / sqrtf(ss * (1.0f / 64.0f) + 1e-6f);
#pragma unroll
                    for (int bj = 0; bj < 2; ++bj) { v[bj][0] = v[bj][0] * (rstd * qs) * g0[bj]; v[bj][1] = v[bj][1] * (rstd * qs) * g1[bj]; } }
#pragma unroll
                for (int bj = 0; bj < 2; ++bj) { u32x4 w; w.x = cvt_pk_bf16(v[bj][0][0], v[bj][0][1]); w.y = cvt_pk_bf16(v[bj][0][2], v[bj][0][3]); w.z = cvt_pk_bf16(v[bj][1][0], v[bj][1][1]); w.w = cvt_pk_bf16(v[bj][1][2], v[bj][1][3]);
                    *(u32x4*)(Z + (size_t)row * 4096 + zc + 32 * bj) = w; }
                if (kind >= 1 && row < 8192) { float* op = (kind == 1 ? newk : newv) + ((size_t)((row >> 8) * 8 + h) * 256 + (row & 255)) * 64 + 8 * fq;
#pragma unroll
                    for (int bj = 0; bj < 2; ++bj) { *(f32x4*)(op + 32 * bj) = v[bj][0]; *(f32x4*)(op + 32 * bj + 4) = v[bj][1]; } } }
    }
};

template <class Epi, class Sched, bool ALIGN_EPI = false, bool SP2 = false>
__device__ __forceinline__ void gemm_phase(PG8_LAS unsigned char* lds, const Gemm g, const Sched& S, const Epi& E) {
    const int tid = threadIdx.x, wid = __builtin_amdgcn_readfirstlane(tid >> 6), lane = tid & 63, wr = wid >> 2, wc = wid & 3, fr = lane & 15, fq = lane >> 4;
    const int K = g.K, nt = K / BK;
    unsigned voffA[2], voffB[2];
#pragma unroll
    for (int i = 0; i < 2; ++i) { int R, C; stage_rc(tid * 16 + i * 8192, R, C); const int Rb = Epi::PERM ? ((R & ~31) + perm32(R & 31)) : R;
        const int Ra = Epi::APERM ? ((R & ~63) + 4 * (R & 15) + ((R >> 4) & 3)) : R;
        voffA[i] = (unsigned)(Ra * K + C) * 2u; voffB[i] = (unsigned)(Rb * K + C) * 2u; }
    const size_t kstep = (size_t)(BK * 2);
    const size_t hstep = (size_t)HALF * K * 2;
    const size_t tstep = 2 * hstep;
    const unsigned ldsw = (unsigned)wid * 1024u;
    const int aoff = lds_byte(wr * 64 + fr, fq * 8), boff = lds_byte(wc * 32 + fr, fq * 8);
#define PG8_SA(b, h) (((b) * 2 + (h)) * HTB)
#define PG8_SB(b, h) ((4 + (b) * 2 + (h)) * HTB)
#define PG8_STAGE(bufoff, gbase, voff) do { _Pragma("unroll") for (int _i = 0; _i < 2; ++_i) \
        __builtin_amdgcn_global_load_lds((const unsigned*)((const char*)(gbase) + (voff)[_i]), (PG8_LAS unsigned*)(lds + (bufoff) + ldsw + _i * 8192), 16, 0, 0); } while (0)
#define PG8_LDA(dst, b, h) do { _Pragma("unroll") for (int m = 0; m < 4; ++m) _Pragma("unroll") for (int k = 0; k < 2; ++k) dst[m][k] = *(const PG8_LAS bf16x8*)(lds + PG8_SA(b, h) + aoff + m * 2048 + k * 1024); } while (0)
#define PG8_LDB(dst, b, h) do { _Pragma("unroll") for (int n = 0; n < 2; ++n) _Pragma("unroll") for (int k = 0; k < 2; ++k) dst[n][k] = *(const PG8_LAS bf16x8*)(lds + PG8_SB(b, h) + boff + n * 2048 + k * 1024); } while (0)
#define PG8_MMA(ai, bj, At, Bt) do { __builtin_amdgcn_s_setprio(1); _Pragma("unroll") for (int m = 0; m < 4; ++m) _Pragma("unroll") for (int n = 0; n < 2; ++n) _Pragma("unroll") for (int k = 0; k < 2; ++k) \
        acc[ai][bj][m][n] = __builtin_amdgcn_mfma_f32_16x16x32_bf16(Bt[n][k], At[m][k], acc[ai][bj][m][n], 0, 0, 0); __builtin_amdgcn_s_setprio(0); } while (0)
#define PG8_WAIT_V(n) asm volatile("s_waitcnt vmcnt(" #n ")" ::: "memory")
#define PG8_WAIT_L(n) asm volatile("s_waitcnt lgkmcnt(" #n ")" ::: "memory")
#define PG8_BAR __builtin_amdgcn_s_barrier()
#define PG8_SCHED __builtin_amdgcn_sched_barrier(0)
    Unit cur, nxt; int ui = 0;
    if (!S.next(0, cur)) return;
    f32x4 acc[2][2][4][2];
#pragma unroll
    for (int a = 0; a < 2; ++a)
#pragma unroll
        for (int b = 0; b < 2; ++b)
#pragma unroll
            for (int m = 0; m < 4; ++m)
#pragma unroll
                for (int n = 0; n < 2; ++n) acc[a][b][m][n] = (f32x4){0.f, 0.f, 0.f, 0.f};
    bf16x8 At[4][2], B0[2][2], B1[2][2];
    const size_t rowb = (size_t)K * 2; const char* cA = (const char*)g.A + (size_t)cur.arow * rowb; const char* cB = (const char*)g.Bt + (size_t)cur.pn * tstep;
    S.a_ready(cur);
    if constexpr (SP2) {
        PG8_STAGE(PG8_SB(0, 0), cB, voffB); PG8_STAGE(PG8_SB(0, 1), cB + hstep, voffB); PG8_STAGE(PG8_SA(0, 0), cA, voffA); PG8_STAGE(PG8_SA(0, 1), cA + hstep, voffA);
        if (wr == 1) PG8_BAR;
        PG8_WAIT_V(2); PG8_BAR;
        PG8_STAGE(PG8_SB(1, 0), cB + kstep, voffB); PG8_STAGE(PG8_SA(1, 0), cA + kstep, voffA); PG8_STAGE(PG8_SB(1, 1), cB + hstep + kstep, voffB);
        PG8_WAIT_V(6); PG8_BAR;
    } else {
        PG8_STAGE(PG8_SB(0, 0), cB, voffB); PG8_STAGE(PG8_SA(0, 0), cA, voffA); PG8_STAGE(PG8_SB(0, 1), cB + hstep, voffB); PG8_STAGE(PG8_SA(0, 1), cA + hstep, voffA);
        if (wr == 1) PG8_BAR;
        PG8_WAIT_V(4); PG8_BAR;
        PG8_STAGE(PG8_SB(1, 0), cB + kstep, voffB); PG8_STAGE(PG8_SA(1, 0), cA + kstep, voffA); PG8_STAGE(PG8_SB(1, 1), cB + hstep + kstep, voffB);
        PG8_WAIT_V(6); PG8_BAR;
    }
    for (;;) {
        const bool has_next = S.next(ui + 1, nxt);
        const char* nA = has_next ? (const char*)g.A + (size_t)nxt.arow * rowb : cA; const char* nB = has_next ? (const char*)g.Bt + (size_t)nxt.pn * tstep : cB;
        for (int t = 0; t < nt; t += 2) {
            const bool last = (t == nt - 2);
            const char* a1 = cA + (size_t)(t + 1) * kstep;
            const char* a2 = last ? nA : cA + (size_t)(t + 2) * kstep; const char* b2 = last ? nB : cB + (size_t)(t + 2) * kstep;
            const char* a3 = a2 + kstep; const char* b3 = b2 + kstep;
            if (last && has_next) S.a_ready(nxt);
            if constexpr (SP2) {
            PG8_LDB(B0, 0, 0); PG8_LDB(B1, 0, 1); PG8_SCHED; PG8_LDA(At, 0, 0); PG8_STAGE(PG8_SA(1, 1), a1 + hstep, voffA);
            PG8_WAIT_V(8); PG8_WAIT_L(0); PG8_BAR; PG8_MMA(0, 0, At, B0); PG8_MMA(0, 1, At, B1); PG8_BAR; PG8_SCHED;
            PG8_LDA(At, 0, 1); PG8_STAGE(PG8_SB(0, 0), b2, voffB); PG8_STAGE(PG8_SB(0, 1), b2 + hstep, voffB); PG8_STAGE(PG8_SA(0, 0), a2, voffA);
            PG8_WAIT_V(8); PG8_WAIT_L(0); PG8_BAR; PG8_MMA(1, 0, At, B0); PG8_MMA(1, 1, At, B1); PG8_BAR; PG8_SCHED;
            PG8_LDB(B0, 1, 0); PG8_LDB(B1, 1, 1); PG8_SCHED; PG8_LDA(At, 1, 0); PG8_STAGE(PG8_SA(0, 1), a2 + hstep, voffA);
            PG8_WAIT_V(8); PG8_WAIT_L(0); PG8_BAR; PG8_MMA(0, 0, At, B0); PG8_MMA(0, 1, At, B1); PG8_BAR; PG8_SCHED;
            PG8_LDA(At, 1, 1); PG8_STAGE(PG8_SB(1, 0), b3, voffB); PG8_STAGE(PG8_SB(1, 1), b3 + hstep, voffB); PG8_STAGE(PG8_SA(1, 0), a3, voffA);
            PG8_WAIT_V(8); PG8_WAIT_L(0); PG8_BAR; PG8_MMA(1, 0, At, B0); PG8_MMA(1, 1, At, B1); PG8_BAR; PG8_SCHED;
            } else {
            PG8_LDB(B0, 0, 0); PG8_SCHED; PG8_LDA(At, 0, 0); PG8_STAGE(PG8_SA(1, 1), a1 + hstep, voffA);
            PG8_WAIT_L(8); PG8_BAR; PG8_WAIT_L(0); PG8_MMA(0, 0, At, B0); PG8_BAR; PG8_SCHED;
            PG8_LDB(B1, 0, 1); PG8_STAGE(PG8_SB(0, 0), b2, voffB);
            PG8_BAR; PG8_WAIT_L(0); PG8_MMA(0, 1, At, B1); PG8_BAR;
            PG8_LDA(At, 0, 1); PG8_STAGE(PG8_SA(0, 0), a2, voffA);
            PG8_BAR; PG8_WAIT_L(0); PG8_MMA(1, 0, At, B0); PG8_BAR; PG8_SCHED;
            PG8_STAGE(PG8_SB(0, 1), b2 + hstep, voffB);
            PG8_WAIT_V(6); PG8_BAR; PG8_MMA(1, 1, At, B1); PG8_BAR;
            PG8_LDB(B0, 1, 0); PG8_SCHED; PG8_LDA(At, 1, 0); PG8_STAGE(PG8_SA(0, 1), a2 + hstep, voffA);
            PG8_WAIT_L(8); PG8_BAR; PG8_WAIT_L(0); PG8_MMA(0, 0, At, B0); PG8_BAR; PG8_SCHED;
            PG8_LDB(B1, 1, 1); PG8_STAGE(PG8_SB(1, 0), b3, voffB);
            PG8_BAR; PG8_WAIT_L(0); PG8_MMA(0, 1, At, B1); PG8_BAR;
            PG8_LDA(At, 1, 1); PG8_STAGE(PG8_SA(1, 0), a3, voffA);
            PG8_BAR; PG8_WAIT_L(0); PG8_MMA(1, 0, At, B0); PG8_BAR; PG8_SCHED;
            PG8_STAGE(PG8_SB(1, 1), b3 + hstep, voffB);
            PG8_WAIT_V(6); PG8_BAR; PG8_MMA(1, 1, At, B1); PG8_BAR;
            }
        }
        if constexpr (ALIGN_EPI) { if (wr == 0) PG8_BAR; }
        if constexpr (!Epi::AFTER_DRAIN) { E(acc, cur, wr, wc, fr, fq); S.done(cur); }
        if (!has_next) break;
#pragma unroll
        for (int a = 0; a < 2; ++a)
#pragma unroll
            for (int b = 0; b < 2; ++b)
#pragma unroll
                for (int m = 0; m < 4; ++m)
#pragma unroll
                    for (int n = 0; n < 2; ++n) acc[a][b][m][n] = (f32x4){0.f, 0.f, 0.f, 0.f};
        cur = nxt; cA = nA; cB = nB; ++ui;
        if constexpr (ALIGN_EPI) { if (wr == 1) PG8_BAR; }
    }
    PG8_WAIT_V(0);
    if constexpr (!ALIGN_EPI) { if (wr == 0) PG8_BAR; }
    PG8_BAR;
    if constexpr (Epi::AFTER_DRAIN) { E.fused(acc, cur, wr, wc, fr, fq, lds, wid, lane); S.done(cur); }
#undef PG8_SA
#undef PG8_SB
#undef PG8_STAGE
#undef PG8_LDA
#undef PG8_LDB
#undef PG8_MMA
#undef PG8_WAIT_V
#undef PG8_WAIT_L
#undef PG8_BAR
#undef PG8_SCHED
}
}
#define GAS __attribute__((address_space(1)))
#define LAS __attribute__((address_space(3)))
typedef unsigned short bf16;
typedef unsigned v4u __attribute__((ext_vector_type(4)));
typedef float f32x4 __attribute__((ext_vector_type(4)));
typedef short bf16x8 __attribute__((ext_vector_type(8)));
typedef GAS unsigned gu32;
typedef GAS unsigned long long gu64;
#define RLX_AGENT __ATOMIC_RELAXED, __HIP_MEMORY_SCOPE_AGENT
#define LDS_WAIT() asm volatile("s_waitcnt lgkmcnt(0)" ::: "memory")
#define VM_WAIT() asm volatile("s_waitcnt vmcnt(0)" ::: "memory")
__device__ __forceinline__ unsigned long long rt() { return __builtin_amdgcn_s_memrealtime(); }
__device__ __forceinline__ unsigned f2bf(float f) { unsigned u = __builtin_bit_cast(unsigned, f); return (u + 0x7fffu + ((u >> 16) & 1u)) >> 16; }
__device__ __forceinline__ unsigned pk2(float lo, float hi) { return f2bf(lo) | (f2bf(hi) << 16); }

#define XB_TMO      128
#define XB_XCNT(j)  (256  + 64 * (j))
#define XB_XSUB(j)  (1280 + 64 * (j))
#define XB_XGEN(j)  (2304 + 64 * (j))
#define XB_TOP      3328
#define XB_TOPGEN   3392
#define XCD_BAR_WORDS 3456
#define XB_SPIN_CAP (1u << 18)

__device__ __forceinline__ unsigned xb_ld(unsigned* p)              { return __hip_atomic_load(p, __ATOMIC_RELAXED, __HIP_MEMORY_SCOPE_AGENT); }
__device__ __forceinline__ unsigned xb_add(unsigned* p, unsigned v) { return __hip_atomic_fetch_add(p, v, __ATOMIC_RELAXED, __HIP_MEMORY_SCOPE_AGENT); }
__device__ __forceinline__ unsigned xb_xcc_id() { return (unsigned)__builtin_amdgcn_s_getreg((3 << 11) | 20) & 0xFu; }
#define XB_SPIN(cond, bar) do { unsigned _sp = 0; while (cond) { __builtin_amdgcn_s_sleep(1); \
    if ((++_sp & 255u) == 0u) { if (xb_ld(&(bar)[XB_TMO])) break; if (_sp > XB_SPIN_CAP) { atomicAdd(&(bar)[XB_TMO], 1u); break; } } } } while (0)

struct XcdBarrier {
    unsigned* bar; unsigned x;
    volatile LAS unsigned* st;
};

__device__ __forceinline__ XcdBarrier xcd_barrier_post(unsigned* bar, volatile LAS unsigned* st) {
    XcdBarrier b; b.bar = bar; b.x = xb_xcc_id(); b.st = st;
    if (threadIdx.x == 0) (void)xb_add(&bar[XB_XCNT(b.x)], 1u);
    return b;
}
__device__ __forceinline__ void xcd_barrier_complete(unsigned* bar, unsigned x, unsigned& nloc, unsigned& nx) {
    const unsigned G = gridDim.x * gridDim.y * gridDim.z;
    unsigned sum, cnt, mine, sp = 0u;
    for (;;) {
        sum = 0u; cnt = 0u; mine = 0u;
#pragma unroll
        for (unsigned j = 0; j < 16; ++j) { const unsigned c = xb_ld(&bar[XB_XCNT(j)]); sum += c; cnt += (c > 0u) ? 1u : 0u; mine = (j == x) ? c : mine; }
        if (sum == G) break;
        __builtin_amdgcn_s_sleep(1);
        if ((++sp & 255u) == 0u) { if (xb_ld(&bar[XB_TMO])) break; if (sp > XB_SPIN_CAP) { atomicAdd(&bar[XB_TMO], 1u); break; } }
    }
    nloc = mine > 0u ? mine : 1u; nx = cnt > 0u ? cnt : 1u;
}

__device__ __forceinline__ void xcd_barrier(const XcdBarrier& b) {
    asm volatile("s_waitcnt vmcnt(0)" ::: "memory");
    __syncthreads();
    if (threadIdx.x == 0) {
        unsigned* bar = b.bar;
        __builtin_amdgcn_s_waitcnt(0);
        unsigned nloc = b.st[0], nx = b.st[1];
        if (nloc == 0u) { xcd_barrier_complete(bar, b.x, nloc, nx); b.st[0] = nloc; b.st[1] = nx; }
        const unsigned old = xb_add(&bar[XB_XSUB(b.x)], 1u);
        const unsigned gen = old / nloc;
        if (old + 1u == (gen + 1u) * nloc) {
            __builtin_amdgcn_fence(__ATOMIC_RELEASE, "agent");
            asm volatile("s_waitcnt vmcnt(0)" ::: "memory");
            const unsigned og = xb_add(&bar[XB_TOP], 1u);
            const unsigned tg = og / nx;
            if (og + 1u == (tg + 1u) * nx) xb_add(&bar[XB_TOPGEN], 1u);
            else XB_SPIN(xb_ld(&bar[XB_TOPGEN]) == tg, bar);
            __builtin_amdgcn_fence(__ATOMIC_ACQUIRE, "agent");
            xb_add(&bar[XB_XGEN(b.x)], 1u);
            asm volatile("s_waitcnt vmcnt(0)" ::: "memory");
        } else {
            XB_SPIN(xb_ld(&bar[XB_XGEN(b.x)]) == gen, bar);
            __builtin_amdgcn_fence(__ATOMIC_ACQUIRE, "agent");
            asm volatile("s_waitcnt vmcnt(0)" ::: "memory");
        }
    }
    __syncthreads();
}
constexpr int NWAVES = 8;
constexpr int DM = 1024, NCTX = 8192, NLAT = 4096, MTOK = NCTX + NLAT, DIN = 4096, DFF = 2816, NUP = 2 * DFF, NMOD = 6 * DM;
constexpr int ZP = 4096;
constexpr float EPS = 1e-6f;
constexpr int NPH = 8;
constexpr size_t MiB = 1u << 20;
constexpr size_t WS_CTL = 0, CTL_ZERO_BYTES = 1 * MiB;
constexpr size_t WS_ROWSS = 128 * 1024;
constexpr size_t WS_BUP = 256 * 1024;
constexpr size_t WS_MOD = 512 * 1024;
constexpr size_t WS_WIN = 1 * MiB, WS_WP = 9 * MiB, WS_WN = 10 * MiB, WS_WO = 11 * MiB, WS_WUP = 13 * MiB, WS_WD = 24 * MiB, WS_WPOOL = 30 * MiB;
constexpr size_t WS_CK = 30 * MiB + 512 * 1024, WS_CV = 31 * MiB + 512 * 1024;
constexpr size_t WS_XN = 33 * MiB;
constexpr size_t WS_Z = 57 * MiB;
constexpr size_t WS_U = 57 * MiB;
constexpr size_t WS_NA = 189 * MiB, WS_MIX = 201 * MiB, WS_MB = 213 * MiB;
constexpr size_t WS_ACT = 189 * MiB;
constexpr size_t WS_END = 256 * MiB;
static_assert(WS_U + (size_t)MTOK * NUP * 2 <= WS_NA && WS_ACT + (size_t)MTOK * DFF * 2 <= WS_END && WS_MB + (size_t)MTOK * DM * 2 <= WS_END, "ws map");
constexpr int CW_BAR = 4096;
constexpr int RING_OFF = 0, RING_BYTES = 131072;
constexpr int LDSCTL_OFF = RING_BYTES, MISC_OFF = LDSCTL_OFF + 320;
constexpr int LDS_BYTES = 147456;

#define LAS __attribute__((address_space(3)))
typedef unsigned short bf16;
typedef unsigned v4u __attribute__((ext_vector_type(4)));
typedef unsigned v2u __attribute__((ext_vector_type(2)));
typedef float f32x4 __attribute__((ext_vector_type(4)));
typedef float f32x16 __attribute__((ext_vector_type(16)));
typedef short bf16x8 __attribute__((ext_vector_type(8)));
typedef short s16x4 __attribute__((ext_vector_type(4)));
#define LDS_WAIT() asm volatile("s_waitcnt lgkmcnt(0)" ::: "memory")
using pg8::cvt_pk_bf16; using pg8::bf_lo; using pg8::bf_hi;

struct Args { const float* in[23]; float* out; unsigned char* ws; int ph_lo, ph_hi; };

__device__ __forceinline__ float wave_sum(float v) {
#pragma unroll
    for (int o = 1; o < 64; o <<= 1) v += __shfl_xor(v, o);
    return v;
}
__device__ __forceinline__ float siluf_(float x) { return x * __builtin_amdgcn_rcpf(1.0f + __builtin_amdgcn_exp2f(-1.4426950408889634f * x)); }

struct TrItem { const float* W; bf16* WT; int K, N, k0, n0, drow, bup; };
__device__ __forceinline__ void tr_load(const TrItem& t, int lane, f32x4 (&tv)[8]) {
#pragma unroll
    for (int i = 0; i < 8; ++i) tv[i] = *(const f32x4*)(t.W + (size_t)(t.k0 + (lane >> 3) + 8 * i) * t.N + t.n0 + 4 * (lane & 7));
}
__device__ __forceinline__ void tr_store(const TrItem& t, LAS float* scr, int lane, const f32x4 (&tv)[8]) {
#pragma unroll
    for (int i = 0; i < 8; ++i) { LAS float* p = scr + ((lane >> 3) + 8 * i) * 33 + 4 * (lane & 7); p[0] = tv[i][0]; p[1] = tv[i][1]; p[2] = tv[i][2]; p[3] = tv[i][3]; }
    LDS_WAIT(); asm volatile("" ::: "memory");
    const int c = lane & 7;
#pragma unroll
    for (int j = 0; j < 4; ++j) { const int n = (lane >> 3) + 8 * j; const LAS float* s_ = scr + (8 * c) * 33 + n;
        v4u o; o.x = cvt_pk_bf16(s_[0 * 33], s_[1 * 33]); o.y = cvt_pk_bf16(s_[2 * 33], s_[3 * 33]); o.z = cvt_pk_bf16(s_[4 * 33], s_[5 * 33]); o.w = cvt_pk_bf16(s_[6 * 33], s_[7 * 33]);
        *(v4u*)(t.WT + (size_t)(t.drow + n) * t.K + t.k0 + 8 * c) = o; }
    LDS_WAIT(); asm volatile("" ::: "memory");
}
__device__ __forceinline__ void tr_bup(const TrItem& t, const float* MOD, float* BUP, int lane, const f32x4 (&tv)[8]) {
    f32x4 b0 = {0.f, 0.f, 0.f, 0.f}, b1 = b0, b2 = b0;
#pragma unroll
    for (int i = 0; i < 8; ++i) { const int k = t.k0 + (lane >> 3) + 8 * i; b0 += tv[i] * MOD[3 * DM + k]; b1 += tv[i] * MOD[NMOD + 3 * DM + k]; b2 += tv[i] * MOD[2 * NMOD + 3 * DM + k]; }
#pragma unroll
    for (int o = 8; o < 64; o <<= 1)
#pragma unroll
        for (int e = 0; e < 4; ++e) { b0[e] += __shfl_xor(b0[e], o); b1[e] += __shfl_xor(b1[e], o); b2[e] += __shfl_xor(b2[e], o); }
    if (lane < 8) { float* p = BUP + t.n0 + 4 * lane;
#pragma unroll
        for (int e = 0; e < 4; ++e) { atomicAdd(p + e, b0[e]); atomicAdd(p + NUP + e, b1[e]); atomicAdd(p + 2 * NUP + e, b2[e]); } }
}
__device__ __forceinline__ void p0_gemv(const Args& a, int gw, int NGW, int wave, int lane) {
    unsigned char* ws = a.ws;
    float* MOD = (float*)(ws + WS_MOD);
    const int gwT = wave * (NGW >> 3) + (gw >> 3);
    for (int t = gwT; t < 96 * 16; t += NGW) {
        const int cg = t % 96, ks = t / 96, col = cg * 64 + lane, k0 = ks * 64;
        const float s0 = siluf_(a.in[5][k0 + lane]), s1 = siluf_(a.in[4][k0 + lane]), s2 = siluf_(a.in[4][1024 + k0 + lane]);
        float a0 = 0.f, a1 = 0.f, a2 = 0.f;
        const float* wp = a.in[8] + (size_t)k0 * NMOD + col;
#pragma unroll
        for (int kh = 0; kh < 64; kh += 32) { float wv[32];
#pragma unroll
            for (int kk = 0; kk < 32; ++kk) wv[kk] = wp[(size_t)(kh + kk) * NMOD];
#pragma unroll
            for (int kk = 0; kk < 32; ++kk) { a0 += __shfl(s0, kh + kk) * wv[kk]; a1 += __shfl(s1, kh + kk) * wv[kk]; a2 += __shfl(s2, kh + kk) * wv[kk]; } }
        if (ks == 0) { const float b = a.in[9][col]; a0 += b; a1 += b; a2 += b; }
        atomicAdd(MOD + col, a0); atomicAdd(MOD + NMOD + col, a1); atomicAdd(MOD + 2 * NMOD + col, a2);
    }
}
__device__ __forceinline__ void p1_convert(const Args& a, LAS unsigned char* lds, int gw, int NGW, int wave, int lane) {
    unsigned char* ws = a.ws;
    LAS float* scr = (LAS float*)(lds + RING_OFF + wave * 16384);
    const int gwT = wave * (NGW >> 3) + (gw >> 3);
    typedef __attribute__((address_space(4))) const float cfloat_t;
    for (int ft = gwT; ft < 1024; ft += NGW) {
        const int g = ft >> 8, k0 = (ft & 255) * 4;
        cfloat_t* wrow = (cfloat_t*)(a.in[10] + (size_t)k0 * 4096 + g * 128);
        float2 ac[4];
#pragma unroll
        for (int j = 0; j < 4; ++j) ac[j] = make_float2(0.f, 0.f);
        const float* pw = a.in[13] + (size_t)g * 128 * 128 + 2 * lane;
#pragma unroll 16
        for (int c = 0; c < 128; ++c) { const float2 w2 = *(const float2*)(pw + (size_t)c * 128);
#pragma unroll
            for (int j = 0; j < 4; ++j) { const float wv = wrow[j * 4096 + c]; ac[j].x += wv * w2.x; ac[j].y += wv * w2.y; } }
        const float2 sp = *(const float2*)(a.in[14] + g * 128 + 2 * lane);
        bf16* wt = (bf16*)(ws + WS_WIN) + (size_t)(g * 128 + 2 * lane) * 1024 + k0;
        v2u o; o.x = cvt_pk_bf16(ac[0].x * sp.x, ac[1].x * sp.x); o.y = cvt_pk_bf16(ac[2].x * sp.x, ac[3].x * sp.x);
        *(v2u*)wt = o;
        o.x = cvt_pk_bf16(ac[0].y * sp.y, ac[1].y * sp.y); o.y = cvt_pk_bf16(ac[2].y * sp.y, ac[3].y * sp.y);
        *(v2u*)(wt + 1024) = o;
    }
    constexpr int I_IN = 16 * 112, I_P = 8 * 32, NITEMS = I_IN + 2 * I_P;
#define P1_DECODE(T, it_) do { int r = (it_); \
        if (r < I_IN) { const int kb = r / 112, nb = 16 + r % 112, n0 = nb * 32, pn = n0 >> 8, lc = n0 & 255;   \
            T = TrItem{a.in[10], (bf16*)(ws + WS_WIN), 1024, 4096, kb * 64, n0, (pn >= 2 && pn < 8) ? 256 * pn + 128 * ((lc & 63) >> 5) + 32 * (lc >> 6) : n0, 0}; } \
        else { r -= I_IN; const int w_ = r >= I_P; r -= w_ * I_P; const int kb = r / 32, nb = r % 32; T = TrItem{a.in[16 + w_], (bf16*)(ws + (w_ ? WS_WN : WS_WP)), 512, 1024, kb * 64, nb * 32, nb * 32, 0}; } } while (0)
    for (int it = NGW - 1 - gw; it < NITEMS; it += 2 * NGW) {
        TrItem A, B; f32x4 ta[8], tb[8]; const bool hasB = it + NGW < NITEMS;
        P1_DECODE(A, it); tr_load(A, lane, ta);
        if (hasB) { P1_DECODE(B, it + NGW); tr_load(B, lane, tb); }
        tr_store(A, scr, lane, ta);
        if (hasB) tr_store(B, scr, lane, tb);
    }
#undef P1_DECODE
    for (int i = gw * 64 + lane; i < 2 * 65536; i += NGW * 64) {
        const int t = i >> 16, e = (i & 65535) * 8; const float* src = a.in[2 + t] + e;
        const f32x4 x0 = *(const f32x4*)src, x1 = *(const f32x4*)(src + 4);
        v4u o; o.x = cvt_pk_bf16(x0[0], x0[1]); o.y = cvt_pk_bf16(x0[2], x0[3]); o.z = cvt_pk_bf16(x1[0], x1[1]); o.w = cvt_pk_bf16(x1[2], x1[3]);
        *(v4u*)((bf16*)(ws + (t ? WS_CV : WS_CK)) + e) = o;
    }
}

constexpr int H_O = 16 * 32, H_UP = 16 * 176, H_D = 44 * 32, HITEMS = H_O + H_UP + H_D, HSPLIT = 2560;
__device__ __forceinline__ void late_items(const Args& a, LAS unsigned char* lds, int lo, int hi, int hw, int NHW, int wave, int lane) {
    LAS float* scr = (LAS float*)(lds + RING_OFF + wave * 16384);
    const float* MOD = (const float*)(a.ws + WS_MOD); float* BUP = (float*)(a.ws + WS_BUP);
#define H_DECODE(T, it_) do { int r = (it_); \
        if (r < H_O) { const int kb = r / 32, nb = r % 32; T = TrItem{a.in[18], (bf16*)(a.ws + WS_WO), 1024, 1024, kb * 64, nb * 32, nb * 32, 0}; } \
        else if (r < H_O + H_UP) { r -= H_O; const int kb = r / 176, nb = r % 176, n0 = nb * 32;   \
            T = TrItem{a.in[19], (bf16*)(a.ws + WS_WUP), 1024, NUP, kb * 64, n0, n0 < DFF ? 256 * (n0 / 128) + (n0 % 128) : 256 * ((n0 - DFF) / 128) + 128 + ((n0 - DFF) % 128), 1}; } \
        else { r -= H_O + H_UP; const int kb = r / 32, nb = r % 32; T = TrItem{a.in[22], (bf16*)(a.ws + WS_WD), DFF, 1024, kb * 64, nb * 32, nb * 32, 0}; } } while (0)
    for (int it = lo + hw; it < hi; it += 2 * NHW) {
        TrItem A, B; f32x4 ta[8], tb[8]; const bool hasB = it + NHW < hi;
        H_DECODE(A, it); tr_load(A, lane, ta);
        if (hasB) { H_DECODE(B, it + NHW); tr_load(B, lane, tb); }
        if (A.bup) tr_bup(A, MOD, BUP, lane, ta);
        tr_store(A, scr, lane, ta);
        if (hasB) { if (B.bup) tr_bup(B, MOD, BUP, lane, tb); tr_store(B, scr, lane, tb); }
    }
#undef H_DECODE
}
template <int R> __device__ __forceinline__ void modnorm_rows(const float* x0, const float* x1, bf16* XNo, const float* g, const float* MODp, int sh, int m0, int stride, int lane) {
    f32x4 v[R][4]; float ss[R];
#pragma unroll
    for (int i = 0; i < R; ++i) { const int m = m0 + i * stride, mc = m < MTOK ? m : m0; const float* xr = mc < NCTX ? x0 + (size_t)mc * DM : x1 + (size_t)(mc - NCTX) * DM;
#pragma unroll
        for (int j = 0; j < 4; ++j) v[i][j] = *(const f32x4*)(xr + 256 * j + 4 * lane); }
#pragma unroll
    for (int i = 0; i < R; ++i) { float s = 0.f;
#pragma unroll
        for (int j = 0; j < 4; ++j) s += (v[i][j][0] * v[i][j][0] + v[i][j][1] * v[i][j][1]) + (v[i][j][2] * v[i][j][2] + v[i][j][3] * v[i][j][3]);
        ss[i] = s; }
#pragma unroll
    for (int o = 1; o < 64; o <<= 1) {
#pragma unroll
        for (int i = 0; i < R; ++i) ss[i] += __shfl_xor(ss[i], o); }
#pragma unroll
    for (int i = 0; i < R; ++i) { const int m = m0 + i * stride; if (m < MTOK) {
        const float rstd = 1.0f / sqrtf(ss[i] * (1.f / DM) + EPS); const float* modv = MODp + (m < NCTX ? 0 : 1 + ((m - NCTX) >> 11)) * NMOD;
#pragma unroll
        for (int j = 0; j < 4; ++j) { const int c = 256 * j + 4 * lane;
            const f32x4 gg = *(const f32x4*)(g + c), shf = *(const f32x4*)(modv + sh * 1024 + c), scl = *(const f32x4*)(modv + (sh + 1) * 1024 + c);
            const f32x4 y = v[i][j] * rstd * gg * (scl + 1.0f) + shf;
            v2u o; o.x = cvt_pk_bf16(y[0], y[1]); o.y = cvt_pk_bf16(y[2], y[3]);
            *(v2u*)(XNo + (size_t)m * DM + c) = o; } } }
}


typedef short v4i16_t __attribute__((ext_vector_type(4)));
__device__ __forceinline__ s16x4 vtr(const LAS unsigned char* p) { return __builtin_bit_cast(s16x4, __builtin_amdgcn_ds_read_tr16_b64_v4i16((LAS v4i16_t*)p)); }
constexpr int VS = 144;
constexpr float NEGBIG = -1e30f;
__device__ __forceinline__ int clampi(int x, int lo, int hi) { return x < lo ? lo : (x > hi ? hi : x); }

__device__ __forceinline__ void attn_task(const Args& a, LAS unsigned char* vl, bool latent, int id, int lane) {
    const bf16* Z = (const bf16*)(a.ws + WS_Z);
    const bf16* CK = (const bf16*)(a.ws + WS_CK); const bf16* CV = (const bf16*)(a.ws + WS_CV);
    bf16* NA = (bf16*)(a.ws + WS_NA);
    const int r32 = lane & 31, hi = lane >> 5;
    int b, h, qtok, nblk, qrow = 0, qcol = 0, rlo = 0, bs = 0;
    if (!latent) { const int qb = id & 7; h = (id >> 3) & 7; b = id >> 6; qtok = b * 256 + qb * 32 + r32; nblk = 8; }
    else { const int nq = id & 3, rp = (id >> 2) & 15; h = (id >> 6) & 7; b = id >> 9; qrow = 2 * rp + (r32 >> 4); qcol = 16 * nq + (r32 & 15); qtok = NCTX + b * 2048 + qrow * 64 + qcol;
        rlo = clampi(2 * rp - 4, 0, 24); const int rhi = clampi(2 * rp - 3, 0, 24) + 7; bs = clampi(16 * nq - 8, 0, 32); nblk = 16 + (rhi - rlo + 1); }
    const int rs_q = clampi(qrow - 4, 0, 24), ws_q = clampi(qcol - 8, 0, 48);
    constexpr float L2E = 1.4426950408889634f;
    LAS float* tab = (LAS float*)(vl + 9216);
    if (latent) { const float* rpb = a.in[15] + h * (15 * 31);
#pragma unroll
        for (int i = 0; i < 8; ++i) { const int e = i * 64 + lane; tab[e] = e < 465 ? rpb[e] * L2E : 0.f; } }
    unsigned okc = 0u;
#pragma unroll
    for (int i = 0; i < 16; ++i) { const int kc = bs + (i & 3) + 8 * (i >> 2) + 4 * hi; okc |= ((kc >= ws_q) && (kc < ws_q + 16)) ? (1u << i) : 0u; }
    const int dcb = bs + 4 * hi - qcol + 15;
    bf16x8 qf[4];
#pragma unroll
    for (int s = 0; s < 4; ++s) qf[s] = *(const bf16x8*)(Z + (size_t)qtok * ZP + 512 + h * 64 + 16 * s + 8 * hi);
    constexpr float ATT_THR = 8.0f;
    float mrun = 0.f, lrun = 0.f;
    f32x16 negm = {};
    f32x16 o0 = {}, o1 = {};
    v4u kA[4], kB[4]; v4u vA[4], vB[4];
#define ATT_LOAD(KS, VS_, t) do { const bf16* kp_; const bf16* vp_; int pitch_; \
        if (latent && (t) < 16) { const size_t o_ = ((size_t)(b * 8 + h) * 512 + 32 * (t)) * 64; kp_ = CK + o_; vp_ = CV + o_; pitch_ = 64; } \
        else { const int tok_ = latent ? NCTX + b * 2048 + (rlo + (t) - 16) * 64 + bs : b * 256 + 32 * (t); kp_ = Z + (size_t)tok_ * ZP + 1024 + h * 64; vp_ = kp_ + 512; pitch_ = ZP; } \
        _Pragma("unroll") for (int i = 0; i < 4; ++i) { const int c_ = i * 64 + lane; KS[i] = *(const v4u*)(kp_ + (size_t)(c_ >> 3) * pitch_ + (c_ & 7) * 8); VS_[i] = *(const v4u*)(vp_ + (size_t)(c_ >> 3) * pitch_ + (c_ & 7) * 8); } } while (0)
    const int li = lane & 15;
    const LAS unsigned char* vrd = vl + (4 * hi + (li >> 2)) * VS + (16 * ((lane >> 4) & 1) + 4 * (li & 3)) * 2;
#define ATT_BLOCK(KS, VS_, t, tn, DO_LOAD) do { \
        _Pragma("unroll") for (int i = 0; i < 4; ++i) { const int c_ = i * 64 + lane; *(LAS v4u*)(vl + (c_ >> 3) * VS + (c_ & 7) * 16) = VS_[i]; *(LAS v4u*)(vl + 4608 + (c_ >> 3) * VS + (c_ & 7) * 16) = KS[i]; } \
        bf16x8 kf_[4]; \
        _Pragma("unroll") for (int k = 0; k < 4; ++k) kf_[k] = *(const LAS bf16x8*)(vl + 4608 + r32 * VS + 32 * k + 16 * hi); \
        f32x16 s = negm;                                     \
        _Pragma("unroll") for (int k = 0; k < 4; ++k) s = __builtin_amdgcn_mfma_f32_32x32x16_bf16(kf_[k], qf[k], s, 0, 0, 0); \
        asm volatile("" ::: "memory"); \
        if (DO_LOAD) ATT_LOAD(KS, VS_, (tn)); \
        const bool loc = latent && (t) >= 16; \
        float x[16]; float bm = NEGBIG; \
        if (loc) { const int kr = rlo + (t) - 16; const bool okr = (kr >= rs_q) && (kr < rs_q + 8); \
            const LAS float* tb = tab + (kr - qrow + 7) * 31 + dcb; \
            _Pragma("unroll") for (int i = 0; i < 16; ++i) { const float bias = tb[(i & 3) + 8 * (i >> 2)]; \
                const float v = (okr && ((okc >> i) & 1u)) ? s[i] + bias : NEGBIG; x[i] = v; bm = fmaxf(bm, v); } } \
        else { _Pragma("unroll") for (int i = 0; i < 16; ++i) { x[i] = s[i]; bm = fmaxf(bm, s[i]); } } \
        bm = fmaxf(bm, __shfl_xor(bm, 32)); \
        if ((t) == 0 || __any(bm > ATT_THR)) {                  \
            const float d = (t) == 0 ? bm : fmaxf(bm, 0.f), alpha = (t) == 0 ? 1.0f : __builtin_amdgcn_exp2f(-d); \
            mrun += d; lrun *= alpha; \
            _Pragma("unroll") for (int i = 0; i < 16; ++i) { x[i] -= d; o0[i] *= alpha; o1[i] *= alpha; negm[i] = -mrun; } } \
        float ps = 0.f; \
        _Pragma("unroll") for (int i = 0; i < 16; ++i) { x[i] = __builtin_amdgcn_exp2f(x[i]); ps += x[i]; } \
        lrun += ps; \
        bf16x8 pf[2]; \
        _Pragma("unroll") for (int sp = 0; sp < 2; ++sp) { v4u w; w.x = cvt_pk_bf16(x[8 * sp + 0], x[8 * sp + 1]); w.y = cvt_pk_bf16(x[8 * sp + 2], x[8 * sp + 3]); w.z = cvt_pk_bf16(x[8 * sp + 4], x[8 * sp + 5]); w.w = cvt_pk_bf16(x[8 * sp + 6], x[8 * sp + 7]); pf[sp] = __builtin_bit_cast(bf16x8, w); } \
        _Pragma("unroll") for (int sp = 0; sp < 2; ++sp) { \
            const s16x4 l0 = vtr(vrd + (16 * sp) * VS), h0 = vtr(vrd + (16 * sp + 8) * VS), l1 = vtr(vrd + (16 * sp) * VS + 64), h1 = vtr(vrd + (16 * sp + 8) * VS + 64); \
            const bf16x8 v0 = (bf16x8){l0[0], l0[1], l0[2], l0[3], h0[0], h0[1], h0[2], h0[3]}, v1 = (bf16x8){l1[0], l1[1], l1[2], l1[3], h1[0], h1[1], h1[2], h1[3]}; \
            o0 = __builtin_amdgcn_mfma_f32_32x32x16_bf16(v0, pf[sp], o0, 0, 0, 0); \
            o1 = __builtin_amdgcn_mfma_f32_32x32x16_bf16(v1, pf[sp], o1, 0, 0, 0); } \
        asm volatile("" ::: "memory"); } while (0)
    ATT_LOAD(kA, vA, 0); ATT_LOAD(kB, vB, 1);
    const int npair = nblk >> 1, lastb = nblk - 1;
#define ATT_PAIR(t_) do { const int t = (t_); ATT_BLOCK(kA, vA, t, (t + 2 < lastb ? t + 2 : lastb), true); ATT_BLOCK(kB, vB, t + 1, (t + 3 < lastb ? t + 3 : lastb), true); } while (0)
    int p = 0;
    for (; p < npair; ++p) ATT_PAIR(2 * p);
#undef ATT_PAIR
    if (nblk & 1) ATT_BLOCK(kA, vA, lastb, lastb, false);
#undef ATT_LOAD
#undef ATT_BLOCK
    const float inv = 1.0f / (lrun + __shfl_xor(lrun, 32));
    const int otok = latent ? qtok : (qtok & ~255) + 2 * (qtok & 127) + ((qtok >> 7) & 1);
    bf16* op = NA + (size_t)otok * 512 + h * 64 + 4 * hi;
#pragma unroll
    for (int g = 0; g < 4; ++g) {
        v2u w0; w0.x = cvt_pk_bf16(o0[4 * g] * inv, o0[4 * g + 1] * inv); w0.y = cvt_pk_bf16(o0[4 * g + 2] * inv, o0[4 * g + 3] * inv);
        v2u w1; w1.x = cvt_pk_bf16(o1[4 * g] * inv, o1[4 * g + 1] * inv); w1.y = cvt_pk_bf16(o1[4 * g + 2] * inv, o1[4 * g + 3] * inv);
        *(v2u*)(op + 8 * g) = w0; *(v2u*)(op + 32 + 8 * g) = w1;
    }
}

template <int GI> struct PoolQuad { v4u w[2 << GI]; };
template <int GI> __device__ __forceinline__ void pool_load(const Args& a, int tq, int lane, PoolQuad<GI>& q) {
    const bf16* Z = (const bf16*)(a.ws + WS_Z);
    constexpr int half = 1 << GI;
    const int tok = 4 * tq + (lane >> 4), col = GI * 128 + 8 * (lane & 15);
    const int L = tok < NCTX ? 256 : 2048, s0 = tok < NCTX ? (tok & ~255) : NCTX + ((tok - NCTX) & ~2047), tpos = tok - s0;
#pragma unroll
    for (int o = 0; o < 2 * half; ++o) { const int tp = tpos - half + o; const int tpc = (tp >= 0 && tp < L) ? tp : tpos; q.w[o] = *(const v4u*)(Z + col + (size_t)(s0 + tpc) * ZP); }
}
template <int GI> __device__ __forceinline__ void pool_finish(const Args& a, int tq, int lane, const PoolQuad<GI>& q) {
    bf16* MIX = (bf16*)(a.ws + WS_MIX);
    constexpr int half = 1 << GI;
    const int tok = 4 * tq + (lane >> 4), col = GI * 128 + 8 * (lane & 15);
    const int L = tok < NCTX ? 256 : 2048, s0 = tok < NCTX ? (tok & ~255) : NCTX + ((tok - NCTX) & ~2047), tpos = tok - s0;
    const int lo = tpos - half < 0 ? 0 : tpos - half, hi = tpos + half > L ? L : tpos + half;
    const float rc = 1.0f / (float)(hi - lo);
    float sum[8];
#pragma unroll
    for (int e = 0; e < 8; ++e) sum[e] = 0.f;
#pragma unroll
    for (int o = 0; o < 2 * half; ++o) { const int tp = tpos - half + o; const float mk = (tp >= 0 && tp < L) ? 1.f : 0.f;
        sum[0] += mk * bf_lo(q.w[o].x); sum[1] += mk * bf_hi(q.w[o].x); sum[2] += mk * bf_lo(q.w[o].y); sum[3] += mk * bf_hi(q.w[o].y);
        sum[4] += mk * bf_lo(q.w[o].z); sum[5] += mk * bf_hi(q.w[o].z); sum[6] += mk * bf_lo(q.w[o].w); sum[7] += mk * bf_hi(q.w[o].w); }
    const v4u c = q.w[half];
    v4u p; p.x = cvt_pk_bf16(sum[0] * rc - bf_lo(c.x), sum[1] * rc - bf_hi(c.x)); p.y = cvt_pk_bf16(sum[2] * rc - bf_lo(c.y), sum[3] * rc - bf_hi(c.y));
    p.z = cvt_pk_bf16(sum[4] * rc - bf_lo(c.z), sum[5] * rc - bf_hi(c.z)); p.w = cvt_pk_bf16(sum[6] * rc - bf_lo(c.w), sum[7] * rc - bf_hi(c.w));
    *(v4u*)(MIX + (size_t)tok * 512 + col) = p;
}
template <int GI> __device__ __forceinline__ void pool_run3(const Args& a, int tq0, int lane) {
    PoolQuad<GI> qa, qb;
    pool_load<GI>(a, tq0, lane, qa); pool_load<GI>(a, tq0 + 1, lane, qb);
    asm volatile("" ::: "memory");
    pool_finish<GI>(a, tq0, lane, qa);
    pool_load<GI>(a, tq0 + 2, lane, qa);
    asm volatile("" ::: "memory");
    pool_finish<GI>(a, tq0 + 1, lane, qb);
    pool_finish<GI>(a, tq0 + 2, lane, qa);
}

__global__ void __launch_bounds__(NWAVES * 64, 2) fwd_kernel(Args args) {
    extern __shared__ __attribute__((aligned(16))) unsigned char lds_raw[];
    LAS unsigned char* lds = (LAS unsigned char*)lds_raw;
    volatile LAS unsigned* MISC = (volatile LAS unsigned*)(lds + MISC_OFF);
    const int tid = threadIdx.x, lane = tid & 63, wave = __builtin_amdgcn_readfirstlane(tid >> 6);
    const int G = gridDim.x, bx = blockIdx.x, vcu = (G % 8 == 0) ? (bx % 8) * (G / 8) + bx / 8 : bx;
    const int gw = vcu * NWAVES + wave, NGW = G * NWAVES;
    unsigned char* ws = args.ws;
    for (int u = tid; u < (LDS_BYTES - LDSCTL_OFF) / 4; u += NWAVES * 64) ((LAS unsigned*)(lds + LDSCTL_OFF))[u] = 0u;
    __syncthreads();
#if MK_PER_PHASE
#define GRID_BAR() do { } while (0)
#else
    XcdBarrier bar = xcd_barrier_post((unsigned*)(ws + WS_CTL) + CW_BAR, MISC + 8);
#define GRID_BAR() xcd_barrier(bar)
#endif
    const int lo = args.ph_lo, hi = args.ph_hi;
#define IN(k) (lo <= (k) && (k) < hi)
#define SEAM(k) do { if (IN(k) && IN((k) + 1)) GRID_BAR(); } while (0)
    const float* MOD = (const float*)(ws + WS_MOD);
    bf16* XN = (bf16*)(ws + WS_XN); bf16* Zb = (bf16*)(ws + WS_Z);
    float* Y = args.out;

    if (IN(0)) { p0_gemv(args, gw, NGW, wave, lane); } SEAM(0);
    if (IN(1)) {
        p1_convert(args, lds, gw, NGW, wave, lane);
        for (int m0 = gw; m0 < MTOK; m0 += 6 * NGW) modnorm_rows<6>(args.in[0], args.in[1], XN, args.in[6], MOD, 0, m0, NGW, lane); } SEAM(1);
    if (IN(2)) { pg8::Gemm g{XN, (const bf16*)(ws + WS_WIN), MTOK, DIN, DM}; pg8::StaticOrder S; S.init(MTOK, DIN, G, bx);
        pg8::EpiQKV E{Zb, args.in[11], args.in[12], Y + (size_t)MTOK * DM, Y + (size_t)MTOK * DM + (size_t)NCTX * 512}; pg8::gemm_phase<pg8::EpiQKV, pg8::StaticOrder, true, true>(lds + RING_OFF, g, S, E); } SEAM(2);
    if (IN(3)) {
        LAS unsigned char* vl = lds + RING_OFF + wave * 16384;
        if (wave < 4) { for (int id = vcu * 4 + wave; id < 1024; id += G * 4) attn_task(args, vl, true, id, lane); }
        else { for (int id = vcu * 4 + (wave - 4); id < 1024; id += G * 4) { attn_task(args, vl, false, 2 * id, lane); attn_task(args, vl, false, 2 * id + 1, lane); } }
        for (int tb = vcu * 12; tb < MTOK / 4; tb += G * 12) { const int tq0 = tb + 3 * (wave & 3);
            if (wave < 4) { pool_run3<0>(args, tq0, lane); pool_run3<1>(args, tq0, lane); } else { pool_run3<2>(args, tq0, lane); pool_run3<3>(args, tq0, lane); } }
    } SEAM(3);
    const bool helper = G > 192 ? bx >= 192 : true; const int NHW = (G > 192 ? G - 192 : G) * NWAVES, hw = (G > 192 ? bx - 192 : bx) * NWAVES + wave;
    if (IN(4)) { bf16* T1 = XN;
        if (helper) late_items(args, lds, 0, HSPLIT, hw, NHW, wave, lane);
        { pg8::Gemm g{(const bf16*)(ws + WS_MIX), (const bf16*)(ws + WS_WP), MTOK, DM, 512}; pg8::StaticOrder S; S.init(MTOK, DM, G, bx);
          pg8::EpiStoreBf16 E{T1, DM}; pg8::gemm_phase<pg8::EpiStoreBf16, pg8::StaticOrder, true, true>(lds + RING_OFF, g, S, E); }
        asm volatile("s_waitcnt vmcnt(0)" ::: "memory"); __syncthreads();
        { pg8::Gemm g{(const bf16*)(ws + WS_NA), (const bf16*)(ws + WS_WN), MTOK, DM, 512}; pg8::StaticOrder S; S.init(MTOK, DM, G, bx);
          pg8::EpiMerge E{T1, Zb, (bf16*)(ws + WS_MB)}; pg8::gemm_phase<pg8::EpiMerge, pg8::StaticOrder, true, true>(lds + RING_OFF, g, S, E); }
    } SEAM(4);
    if (IN(5)) { if (helper) late_items(args, lds, HSPLIT, HITEMS, hw, NHW, wave, lane);
        pg8::Gemm g{(const bf16*)(ws + WS_MB), (const bf16*)(ws + WS_WO), MTOK, DM, DM}; pg8::StaticOrder S; S.init(MTOK, DM, G, bx);
        pg8::EpiResidNorm E{args.in[0], args.in[1], Y, MOD + 2 * DM, args.in[7], MOD + 4 * DM, XN, (float*)(ws + WS_ROWSS)}; pg8::gemm_phase<pg8::EpiResidNorm, pg8::StaticOrder, true, true>(lds + RING_OFF, g, S, E); } SEAM(5);
    if (IN(6)) { pg8::Gemm g{XN, (const bf16*)(ws + WS_WUP), 50 * 256, NUP, DM}; pg8::UpOrder S; S.init(50 * 256, NUP, G, bx);
        pg8::EpiConvGate E{(bf16*)(ws + WS_ACT), (const float*)(ws + WS_ROWSS), (const float*)(ws + WS_BUP), args.in[20], args.in[21], (LAS float*)(lds + LDSCTL_OFF + 1024)};
        pg8::gemm_phase<pg8::EpiConvGate, pg8::UpOrder, true, true>(lds + RING_OFF, g, S, E); } SEAM(6);
    if (IN(7)) { pg8::Gemm g{(const bf16*)(ws + WS_ACT), (const bf16*)(ws + WS_WD), MTOK, DM, DFF}; pg8::StaticOrder S; S.init(MTOK, DM, G, bx);
        pg8::EpiResid E{Y, Y + (size_t)NCTX * DM, Y, MOD + 5 * DM}; pg8::gemm_phase<pg8::EpiResid, pg8::StaticOrder, true, true>(lds + RING_OFF, g, S, E); }
#undef IN
#undef SEAM
}

extern "C" void kernel_launch(void* const* d_in, const int* in_sizes, int n_in, void* d_out, int out_size, void* d_ws, size_t ws_size, hipStream_t stream) {
    static int grid = 0;
    if (grid == 0) {
        if (n_in != 23 || ws_size < WS_END) { fprintf(stderr, "kernel_launch: unexpected n_in %d / ws %zu\n", n_in, ws_size); grid = -1; return; }
        int dev = 0, cus = 0, per_cu = 0;
        if (hipGetDevice(&dev) != hipSuccess || hipDeviceGetAttribute(&cus, hipDeviceAttributeMultiprocessorCount, dev) != hipSuccess) { grid = -1; return; }
        if (hipFuncSetAttribute((const void*)fwd_kernel, hipFuncAttributeMaxDynamicSharedMemorySize, LDS_BYTES) != hipSuccess) { fprintf(stderr, "kernel_launch: hipFuncSetAttribute failed\n"); grid = -1; return; }
        if (hipOccupancyMaxActiveBlocksPerMultiprocessor(&per_cu, (const void*)fwd_kernel, NWAVES * 64, LDS_BYTES) != hipSuccess || per_cu < 1) { fprintf(stderr, "kernel_launch: occupancy query says %d\n", per_cu); (void)hipGetLastError(); grid = -1; return; }
        grid = cus;
        if (grid % 8) grid -= grid % 8;
    }
    if (grid < 0) return;
    (void)hipMemsetAsync((char*)d_ws + WS_CTL, 0, CTL_ZERO_BYTES, stream);
    Args a{};
    for (int i = 0; i < 23; ++i) a.in[i] = (const float*)d_in[i];
    a.out = (float*)d_out; a.ws = (unsigned char*)d_ws;
#if MK_PER_PHASE
    for (int p = 0; p < NPH; ++p) { a.ph_lo = p; a.ph_hi = p + 1; hipLaunchKernelGGL(fwd_kernel, dim3(grid), dim3(NWAVES * 64), LDS_BYTES, stream, a); }
#else
    a.ph_lo = 0; a.ph_hi = NPH;
    hipLaunchKernelGGL(fwd_kernel, dim3(grid), dim3(NWAVES * 64), LDS_BYTES, stream, a);
#endif
}
```

```cpp
#include <hip/hip_runtime.h>
#include <cstdio>
#include <cstdint>
#ifndef MK_PER_PHASE
#define MK_PER_PHASE 0
#endif
namespace pg8 {
#define PG8_LAS __attribute__((address_space(3)))
typedef unsigned short bf16_t;
typedef short bf16x8 __attribute__((ext_vector_type(8)));
typedef float f32x4 __attribute__((ext_vector_type(4)));
typedef unsigned u32x4 __attribute__((ext_vector_type(4)));
constexpr int BM = 256, BK = 64, HALF = 128, HTB = HALF * BK * 2  , STAGE_BYTES = 8 * HTB, NXCD = 8, WGM = 8;

__host__ __device__ __forceinline__ int lds_byte(int r, int c) { const int st = (r >> 4) * 2 + (c >> 5), rr = r & 15, cc = c & 31, ob = rr * 64 + cc * 2; return st * 1024 + (ob ^ (((ob >> 9) & 1) << 5)); }
__host__ __device__ __forceinline__ void stage_rc(int b, int& R, int& C) { const int st = b / 1024, sb = b % 1024, swz = sb ^ (((sb >> 9) & 1) << 5); R = (st >> 1) * 16 + swz / 64; C = (st & 1) * 32 + (swz % 64) / 2; }
__host__ __device__ __forceinline__ int perm32(int rho) { const int n = rho >> 4, i = rho & 15; return 8 * (i >> 2) + 4 * n + (i & 3); }

struct Unit { int pm, pn, arow, seq; size_t bo; };
struct Gemm { const bf16_t* A; const bf16_t* Bt; int M, N, K; };

struct StaticOrder {
    int nM, nN, nwg, G, c, bm;
    __host__ __device__ void init(int M, int N, int G_, int c_, int bm_ = BM) { bm = bm_; nM = M / bm_; nN = N / BM; nwg = nM * nN; G = G_; c = c_; }
    __host__ __device__ bool next(int i, Unit& u) const {
        const long L = (long)i * G + c; if (L >= nwg) return false;
        int wgid = (int)L; { const int q = nwg / NXCD, r = nwg % NXCD, xcd = wgid % NXCD, off = wgid / NXCD; wgid = (xcd < r ? xcd * (q + 1) : r * (q + 1) + (xcd - r) * q) + off; }
        const int nig = WGM * nN, gid = wgid / nig, fm = gid * WGM, gsz = (nM - fm) < WGM ? (nM - fm) : WGM;
        u.pm = fm + ((wgid % nig) % gsz); u.pn = (wgid % nig) / gsz; u.arow = u.pm * bm; u.seq = i; u.bo = 0; return true;
    }
    __device__ __forceinline__ void a_ready(const Unit&) const {}
    __device__ __forceinline__ void done(const Unit&) const {}
};

typedef float f32x2_t __attribute__((ext_vector_type(2))); typedef __bf16 bf16x2_t __attribute__((ext_vector_type(2)));
__device__ __forceinline__ unsigned cvt_pk_bf16(float lo, float hi) { f32x2_t v = {lo, hi}; bf16x2_t b = __builtin_convertvector(v, bf16x2_t); return __builtin_bit_cast(unsigned, b); }
__device__ __forceinline__ float bf_lo(unsigned w) { return __uint_as_float(w << 16); }
__device__ __forceinline__ float bf_hi(unsigned w) { return __uint_as_float(w & 0xffff0000u); }
__device__ __forceinline__ float sigmoidf_(float x) { return __builtin_amdgcn_rcpf(1.0f + __builtin_amdgcn_exp2f(-1.4426950408889634f * x)); }

struct EpiStoreBf16 {
    static constexpr bool PERM = true, AFTER_DRAIN = false, APERM = false, MIDHOOK = false;
    bf16_t* O; int ldc;
    __device__ __forceinline__ void operator()(const f32x4 (&acc)[2][2][4][2], const Unit& u, int wr, int wc, int fr, int fq) const {
        const int row0 = u.pm * BM + wr * 64 + fr, col0 = u.pn * BM + wc * 32 + 8 * fq;
#pragma unroll
        for (int ai = 0; ai < 2; ++ai)
#pragma unroll
            for (int m = 0; m < 4; ++m) { bf16_t* rowp = O + (size_t)(row0 + ai * HALF + m * 16) * ldc + col0;
#pragma unroll
                for (int bj = 0; bj < 2; ++bj) { const f32x4 v0 = acc[ai][bj][m][0], v1 = acc[ai][bj][m][1];
                    u32x4 w; w.x = cvt_pk_bf16(v0[0], v0[1]); w.y = cvt_pk_bf16(v0[2], v0[3]); w.z = cvt_pk_bf16(v1[0], v1[1]); w.w = cvt_pk_bf16(v1[2], v1[3]);
                    *(u32x4*)(rowp + bj * HALF) = w; } }
    }
};
struct EpiMerge {
    static constexpr bool PERM = true, AFTER_DRAIN = false, APERM = false, MIDHOOK = true;
    const bf16_t* Z; bf16_t* O;
    __device__ __forceinline__ void mid(f32x4 (&acc)[2][2][4][2], const Unit& u, int wr, int wc, int fr, int fq) const {
        int row0 = u.pm * BM + wr * 64 + fr, col0 = u.pn * BM + wc * 32 + 8 * fq;
        asm volatile("" : "+v"(row0), "+v"(col0));
        u32x4 rr[8][2];
#pragma unroll
        for (int grp = 0; grp < 8; ++grp)
#pragma unroll
            for (int bj = 0; bj < 2; ++bj) rr[grp][bj] = *(const u32x4*)(Z + (size_t)(row0 + (grp >> 2) * HALF + (grp & 3) * 16) * 4096 + 2048 + col0 + bj * HALF);
#pragma unroll
        for (int grp = 0; grp < 8; ++grp) { const int ai = grp >> 2, m = grp & 3;
#pragma unroll
            for (int bj = 0; bj < 2; ++bj) { const u32x4 r = rr[grp][bj];
                acc[ai][bj][m][0][0] *= bf_lo(r.x); acc[ai][bj][m][0][1] *= bf_hi(r.x); acc[ai][bj][m][0][2] *= bf_lo(r.y); acc[ai][bj][m][0][3] *= bf_hi(r.y);
                acc[ai][bj][m][1][0] *= bf_lo(r.z); acc[ai][bj][m][1][1] *= bf_hi(r.z); acc[ai][bj][m][1][2] *= bf_lo(r.w); acc[ai][bj][m][1][3] *= bf_hi(r.w); } }
    }
    __device__ __forceinline__ void operator()(const f32x4 (&acc)[2][2][4][2], const Unit& u, int wr, int wc, int fr, int fq) const {
        const int row0 = u.pm * BM + wr * 64 + fr, col0 = u.pn * BM + wc * 32 + 8 * fq;
        u32x4 sn[8][2];
#pragma unroll
        for (int grp = 0; grp < 8; ++grp)
#pragma unroll
            for (int bj = 0; bj < 2; ++bj) sn[grp][bj] = *(const u32x4*)(Z + (size_t)(row0 + (grp >> 2) * HALF + (grp & 3) * 16) * 4096 + 3072 + col0 + bj * HALF);
#pragma unroll
        for (int grp = 0; grp < 8; ++grp) { const int ai = grp >> 2, m = grp & 3; const size_t row = (size_t)(row0 + ai * HALF + m * 16);
#pragma unroll
            for (int bj = 0; bj < 2; ++bj) { const u32x4 g = sn[grp][bj]; const f32x4 v0 = acc[ai][bj][m][0], v1 = acc[ai][bj][m][1];
                u32x4 w; w.x = cvt_pk_bf16(bf_lo(g.x) * v0[0], bf_hi(g.x) * v0[1]); w.y = cvt_pk_bf16(bf_lo(g.y) * v0[2], bf_hi(g.y) * v0[3]);
                w.z = cvt_pk_bf16(bf_lo(g.z) * v1[0], bf_hi(g.z) * v1[1]); w.w = cvt_pk_bf16(bf_lo(g.w) * v1[2], bf_hi(g.w) * v1[3]);
                *(u32x4*)(O + row * 1024 + col0 + bj * HALF) = w; } }
    }
};
struct EpiResid {
    static constexpr bool PERM = false, AFTER_DRAIN = false, APERM = false, MIDHOOK = false;
    const float* base0; const float* base1; float* out; const float* gate;
    __device__ __forceinline__ void operator()(const f32x4 (&acc)[2][2][4][2], const Unit& u, int wr, int wc, int fr, int fq) const {
        const int trow = u.pm * BM, row0 = trow + wr * 64 + fr, col0 = u.pn * BM + wc * 32 + 4 * fq;
        const int mi = trow < 8192 ? 0 : 1 + ((trow - 8192) >> 11);
        const float* bp = trow < 8192 ? base0 : base1 - (size_t)8192 * 1024;
        f32x4 g[2][2];
#pragma unroll
        for (int bj = 0; bj < 2; ++bj)
#pragma unroll
            for (int n = 0; n < 2; ++n) g[bj][n] = *(const f32x4*)(gate + mi * 6144 + col0 + bj * HALF + n * 16);
        f32x4 pre[4][2][2];
#define RS_LOAD(slot, grp) do { const size_t off_ = (size_t)(row0 + ((grp) >> 2) * HALF + ((grp) & 3) * 16) * 1024 + col0; \
            _Pragma("unroll") for (int bj = 0; bj < 2; ++bj) _Pragma("unroll") for (int n = 0; n < 2; ++n) pre[slot][bj][n] = *(const f32x4*)(bp + off_ + bj * HALF + n * 16); } while (0)
        RS_LOAD(0, 0); RS_LOAD(1, 1); RS_LOAD(2, 2); RS_LOAD(3, 3);
#pragma unroll
        for (int grp = 0; grp < 8; ++grp) { const int ai = grp >> 2, m = grp & 3, sl = grp & 3; const size_t off = (size_t)(row0 + ai * HALF + m * 16) * 1024 + col0;
            f32x4 r[2][2];
#pragma unroll
            for (int bj = 0; bj < 2; ++bj)
#pragma unroll
                for (int n = 0; n < 2; ++n) r[bj][n] = pre[sl][bj][n] + g[bj][n] * acc[ai][bj][m][n];
            if (grp + 4 < 8) { if (sl == 0) RS_LOAD(0, grp + 4); else if (sl == 1) RS_LOAD(1, grp + 4); else if (sl == 2) RS_LOAD(2, grp + 4); else RS_LOAD(3, grp + 4); }
            asm volatile("" ::: "memory");
#pragma unroll
            for (int bj = 0; bj < 2; ++bj)
#pragma unroll
                for (int n = 0; n < 2; ++n) *(f32x4*)(out + off + bj * HALF + n * 16) = r[bj][n]; }
#undef RS_LOAD
    }
};

struct EpiResid3 {
    static constexpr bool PERM = false, AFTER_DRAIN = false, APERM = false, MIDHOOK = false;
    float* out; const float* gate; const bf16_t* X1;
    __device__ __forceinline__ static int batch_of(int row) { return row < 8192 ? 0 : 1 + ((row - 8192) >> 11); }
    __device__ __forceinline__ void operator()(const f32x4 (&acc)[2][2][4][2], const Unit& u, int wr, int wc, int fr, int fq) const {
        const int wrow = u.arow + wr * 48, row0 = wrow + fr, col0 = u.pn * BM + wc * 32 + 4 * fq;
        const int mlo = batch_of(wrow), mhi = batch_of(wrow + 96 + 47);
        f32x4 g[2][2][2];
#pragma unroll
        for (int bj = 0; bj < 2; ++bj)
#pragma unroll
            for (int n = 0; n < 2; ++n) { g[0][bj][n] = *(const f32x4*)(gate + mlo * 6144 + col0 + bj * HALF + n * 16); g[1][bj][n] = *(const f32x4*)(gate + mhi * 6144 + col0 + bj * HALF + n * 16); }
        typedef unsigned u32x2 __attribute__((ext_vector_type(2)));
        u32x2 pre[3][2][2];
#define RS_LOAD(slot, grp) do { const size_t off_ = (size_t)(row0 + ((grp) / 3) * 96 + ((grp) % 3) * 16) * 1024 + col0; \
            _Pragma("unroll") for (int bj = 0; bj < 2; ++bj) _Pragma("unroll") for (int n = 0; n < 2; ++n) pre[slot][bj][n] = *(const u32x2*)(X1 + off_ + bj * HALF + n * 16); } while (0)
        RS_LOAD(0, 0); RS_LOAD(1, 1); RS_LOAD(2, 2);
#pragma unroll
        for (int grp = 0; grp < 6; ++grp) { const int ai = grp / 3, m = grp % 3, sl = grp % 3; const size_t off = (size_t)(row0 + ai * 96 + m * 16) * 1024 + col0;
            const bool hi = batch_of(wrow + ai * 96 + m * 16) != mlo;
            f32x4 r[2][2];
#pragma unroll
            for (int bj = 0; bj < 2; ++bj)
#pragma unroll
                for (int n = 0; n < 2; ++n) { const u32x2 p = pre[sl][bj][n]; const f32x4 b = {bf_lo(p.x), bf_hi(p.x), bf_lo(p.y), bf_hi(p.y)}; r[bj][n] = b + (hi ? g[1][bj][n] : g[0][bj][n]) * acc[ai][bj][m][n]; }
            if (grp + 3 < 6) { if (sl == 0) RS_LOAD(0, grp + 3); else if (sl == 1) RS_LOAD(1, grp + 3); else RS_LOAD(2, grp + 3); }
            asm volatile("" ::: "memory");
#pragma unroll
            for (int bj = 0; bj < 2; ++bj)
#pragma unroll
                for (int n = 0; n < 2; ++n) *(f32x4*)(out + off + bj * HALF + n * 16) = r[bj][n]; }
#undef RS_LOAD
    }
};

__host__ __device__ __forceinline__ int up_arow(int pm) { if (pm < 32) return pm * 256; const int q = pm - 32, seq = q / 9, k = q % 9; int st = 254 * k; if (st > 1792) st = 1792; return 8192 + seq * 2048 + st; }
constexpr int UPC_FLOATS = 1536, UPC_ROWSS = 128 * 1024 / 4, UPC_BUP = 256 * 1024 / 4;
struct UpOrder : StaticOrder {
    const float* ctl; const float* cw; const float* cb; PG8_LAS float* cbuf;
    __host__ __device__ bool next(int i, Unit& u) const { if (!StaticOrder::next(i, u)) return false; u.arow = up_arow(u.pm); u.bo = (size_t)(u.pm < 32 ? 0 : 1 + (u.pm - 32) / 9) * ((size_t)5632 * 1024 * 2); return true; }
    __device__ __forceinline__ void a_ready(const Unit& u) const {
        if (__builtin_amdgcn_readfirstlane(threadIdx.x >> 6) != 0) return;
        const int lane = threadIdx.x & 63, mi = u.pm < 32 ? 0 : 1 + (u.pm - 32) / 9;
        int col = (lane < 32 ? 0 : 2816 - 128) + 128 * u.pn + 4 * lane;
        int lz = lane;
        asm volatile("" : "+v"(col), "+v"(lz));
        PG8_LAS float* dst = cbuf + (u.seq & 1) * UPC_FLOATS;
        __builtin_amdgcn_global_load_lds((const unsigned*)(cw + col), (PG8_LAS unsigned*)(dst), 16, 0, 0);
        __builtin_amdgcn_global_load_lds((const unsigned*)(cw + 5632 + col), (PG8_LAS unsigned*)(dst + 256), 16, 0, 0);
        __builtin_amdgcn_global_load_lds((const unsigned*)(cw + 2 * 5632 + col), (PG8_LAS unsigned*)(dst + 512), 16, 0, 0);
        __builtin_amdgcn_global_load_lds((const unsigned*)(cb + col), (PG8_LAS unsigned*)(dst + 768), 16, 0, 0);
        __builtin_amdgcn_global_load_lds((const unsigned*)(ctl + UPC_BUP + mi * 5632 + col), (PG8_LAS unsigned*)(dst + 1024), 16, 0, 0);
#pragma unroll
        for (int i = 0; i < 4; ++i) __builtin_amdgcn_global_load_lds((const unsigned*)(ctl + UPC_ROWSS + u.arow + 64 * i + lz), (PG8_LAS unsigned*)(dst + 1280 + 64 * i), 4, 0, 0);
    }
};
__device__ __forceinline__ float siluf__(float x) { return x * __builtin_amdgcn_rcpf(1.0f + __builtin_amdgcn_exp2f(-1.4426950408889634f * x)); }
struct EpiConvGate {
    static constexpr bool PERM = true, AFTER_DRAIN = false, APERM = true, MIDHOOK = false;
    bf16_t* ACT; PG8_LAS float* xch;
    __device__ __forceinline__ void operator()(f32x4 (&acc)[2][2][4][2], const Unit& u, int wr, int wc, int fr, int fq) const {
        const int pm = u.pm; int wlo = 0, whi = 255;
        if (pm >= 32) { const int k = (pm - 32) % 9; if (k == 0) whi = 254; else if (k < 8) { wlo = 1; whi = 254; } else wlo = 241; }
        asm volatile("" : "+v"(fr), "+v"(fq));
        const int tok0 = u.arow, cbase = 32 * wc + 8 * fq, ca = 128 * u.pn + cbase;
        const PG8_LAS float* cf = xch + 2560 + (u.seq & 1) * UPC_FLOATS;
        {   f32x4 rs[2];
#pragma unroll
            for (int ai = 0; ai < 2; ++ai) { const f32x4 ss = *(const PG8_LAS f32x4*)(cf + 1280 + 128 * ai + 64 * wr + 4 * fr);
#pragma unroll
                for (int m = 0; m < 4; ++m) rs[ai][m] = __builtin_amdgcn_rsqf(ss[m] * (1.0f / 1024.0f) + 1e-6f); }
#pragma unroll
            for (int bj = 0; bj < 2; ++bj)
#pragma unroll
                for (int n = 0; n < 2; ++n) { const f32x4 b = *(const PG8_LAS f32x4*)(cf + 1024 + 128 * bj + cbase + 4 * n);
#pragma unroll
                    for (int ai = 0; ai < 2; ++ai)
#pragma unroll
                        for (int m = 0; m < 4; ++m) acc[ai][bj][m][n] = acc[ai][bj][m][n] * rs[ai][m] + b; } }
        if (fr == 0 || fr == 15) { const int wh = fr == 0 ? 0 : 1;
#pragma unroll
            for (int ai = 0; ai < 2; ++ai)
#pragma unroll
                for (int bj = 0; bj < 2; ++bj)
#pragma unroll
                    for (int n = 0; n < 2; ++n) *(PG8_LAS f32x4*)(xch + (1 + (2 * ai + wr) * 2 + wh) * 256 + 128 * bj + cbase + 4 * n) = fr == 0 ? acc[ai][bj][0][n] : acc[ai][bj][3][n]; }
        asm volatile("s_waitcnt lgkmcnt(0)" ::: "memory"); __builtin_amdgcn_s_barrier(); asm volatile("" ::: "memory");
        typedef unsigned u32x2 __attribute__((ext_vector_type(2)));
#pragma unroll
        for (int ai = 0; ai < 2; ++ai) { const int c = 2 * ai + wr;
#pragma unroll
            for (int m = 0; m < 4; ++m) {
                const int row = 128 * ai + 64 * wr + 4 * fr + m;
                u32x2 keep;
#pragma unroll
                for (int n = 0; n < 2; ++n) {
                    f32x4 sa;
#pragma unroll
                    for (int bj = 0; bj < 2; ++bj) {
                        const int col = 128 * bj + cbase + 4 * n;
                        const f32x4 w0 = *(const PG8_LAS f32x4*)(cf + col), w1 = *(const PG8_LAS f32x4*)(cf + 256 + col), w2 = *(const PG8_LAS f32x4*)(cf + 512 + col), bb = *(const PG8_LAS f32x4*)(cf + 768 + col);
                        f32x4 pv, nv;
                        if (m == 0) { const f32x4 P = *(const PG8_LAS f32x4*)(xch + (2 * c) * 256 + col); const f32x4 c3 = acc[ai][bj][3][n];
#pragma unroll
                            for (int e = 0; e < 4; ++e) pv[e] = __int_as_float(__builtin_amdgcn_update_dpp(__float_as_int(P[e]), __float_as_int(c3[e]), 0x111, 0xf, 0xf, false)); }
                        else pv = acc[ai][bj][m > 0 ? m - 1 : 0][n];
                        if (m == 3) { const f32x4 Nx = *(const PG8_LAS f32x4*)(xch + (2 * c + 3) * 256 + col); const f32x4 c0 = acc[ai][bj][0][n];
#pragma unroll
                            for (int e = 0; e < 4; ++e) nv[e] = __int_as_float(__builtin_amdgcn_update_dpp(__float_as_int(Nx[e]), __float_as_int(c0[e]), 0x101, 0xf, 0xf, false)); }
                        else nv = acc[ai][bj][m < 3 ? m + 1 : 3][n];
                        const f32x4 r = w0 * pv + w1 * acc[ai][bj][m][n] + w2 * nv + bb;
                        if (bj == 0) { sa[0] = siluf__(r[0]); sa[1] = siluf__(r[1]); sa[2] = siluf__(r[2]); sa[3] = siluf__(r[3]); }
                        else sa = sa * r; }
                    u32x2 o; o.x = cvt_pk_bf16(sa[0], sa[1]); o.y = cvt_pk_bf16(sa[2], sa[3]);
                    if (n == 0) keep = o;
                    else if (row >= wlo && row <= whi) { u32x4 o4; o4.x = keep.x; o4.y = keep.y; o4.z = o.x; o4.w = o.y; *(u32x4*)(ACT + (size_t)(tok0 + row) * 2816 + ca) = o4; } } } }
    }
};
struct EpiResidNorm {
    static constexpr bool PERM = true, AFTER_DRAIN = false, APERM = false, MIDHOOK = false;
    const float* base0; const float* base1; bf16_t* X1; const float* gate; float* rowss;
    __device__ __forceinline__ void operator()(const f32x4 (&acc)[2][2][4][2], const Unit& u, int wr, int wc, int fr, int fq) const {
        const int trow = u.pm * BM, row0 = trow + wr * 64 + fr, col0 = u.pn * BM + wc * 32 + 8 * fq;
        const int mi = trow < 8192 ? 0 : 1 + ((trow - 8192) >> 11);
        const float* bp = trow < 8192 ? base0 : base1 - (size_t)8192 * 1024;
        f32x4 g[2][2];
#pragma unroll
        for (int bj = 0; bj < 2; ++bj)
#pragma unroll
            for (int n = 0; n < 2; ++n) { const int c = col0 + bj * HALF + n * 4; g[bj][n] = *(const f32x4*)(gate + mi * 6144 + c); }
        f32x4 pre[2][2][2];
#define RN_LOAD(slot, grp) do { const size_t off_ = (size_t)(row0 + ((grp) >> 2) * HALF + ((grp) & 3) * 16) * 1024 + col0; \
            _Pragma("unroll") for (int bj = 0; bj < 2; ++bj) _Pragma("unroll") for (int n = 0; n < 2; ++n) pre[slot][bj][n] = __builtin_nontemporal_load((const f32x4*)(bp + off_ + bj * HALF + n * 4)); } while (0)
        RN_LOAD(0, 0); RN_LOAD(1, 1);
        typedef unsigned u32x2 __attribute__((ext_vector_type(2)));
#pragma unroll
        for (int grp = 0; grp < 8; ++grp) { const int ai = grp >> 2, m = grp & 3, sl = grp & 1; const size_t off = (size_t)(row0 + ai * HALF + m * 16) * 1024 + col0; float ss = 0.f;
            f32x4 x1[2][2];
#pragma unroll
            for (int bj = 0; bj < 2; ++bj)
#pragma unroll
                for (int n = 0; n < 2; ++n) { x1[bj][n] = pre[sl][bj][n] + g[bj][n] * acc[ai][bj][m][n]; const f32x4 v = x1[bj][n]; ss += (v[0] * v[0] + v[1] * v[1]) + (v[2] * v[2] + v[3] * v[3]); }
            if (grp + 2 < 8) { if (sl == 0) RN_LOAD(0, grp + 2); else RN_LOAD(1, grp + 2); }
            asm volatile("" ::: "memory");
#pragma unroll
            for (int bj = 0; bj < 2; ++bj)
                { u32x4 r4; r4.x = cvt_pk_bf16(x1[bj][0][0], x1[bj][0][1]); r4.y = cvt_pk_bf16(x1[bj][0][2], x1[bj][0][3]); r4.z = cvt_pk_bf16(x1[bj][1][0], x1[bj][1][1]); r4.w = cvt_pk_bf16(x1[bj][1][2], x1[bj][1][3]); *(u32x4*)(X1 + off + bj * HALF) = r4;
                }
            ss += __shfl_xor(ss, 16); ss += __shfl_xor(ss, 32);
            if (fq == 0) atomicAdd(rowss + row0 + ai * HALF + m * 16, ss); }
#undef RN_LOAD
    }
};

struct EpiQKV {
    static constexpr bool PERM = true, AFTER_DRAIN = false, APERM = false, MIDHOOK = false;
    bf16_t* Z; const float* qg; const float* kg; float* newk; float* newv;
    __device__ __forceinline__ void operator()(const f32x4 (&acc)[2][2][4][2], const Unit& u, int wr, int wc, int fr, int fq) const {
        const int row0 = u.pm * BM + wr * 64 + fr, pn = u.pn;
        if (pn >= 8) {
            const int zc = 2048 + 128 * (pn - 8) + wc * 32 + 8 * fq;
#pragma unroll
            for (int ai = 0; ai < 2; ++ai)
#pragma unroll
                for (int m = 0; m < 4; ++m) { bf16_t* rowp = Z + (size_t)(row0 + ai * HALF + m * 16) * 4096 + zc;
                    float R[8], SN[8];
#pragma unroll
                    for (int n = 0; n < 2; ++n)
#pragma unroll
                        for (int e = 0; e < 4; ++e) { const float ep = __builtin_amdgcn_exp2f(fminf(-1.4426950408889634f * acc[ai][0][m][n][e], 40.0f)), en = __builtin_amdgcn_exp2f(fminf(-1.4426950408889634f * acc[ai][1][m][n][e], 40.0f));
                            const float dn_ = 1.0f + en, inv = __builtin_amdgcn_rcpf((1.0f + ep) * dn_);
                            SN[4 * n + e] = (1.0f + ep) * inv; R[4 * n + e] = dn_ * dn_ * inv; }
                    u32x4 w; w.x = cvt_pk_bf16(R[0], R[1]); w.y = cvt_pk_bf16(R[2], R[3]); w.z = cvt_pk_bf16(R[4], R[5]); w.w = cvt_pk_bf16(R[6], R[7]);
                    *(u32x4*)rowp = w;
                    w.x = cvt_pk_bf16(SN[0], SN[1]); w.y = cvt_pk_bf16(SN[2], SN[3]); w.z = cvt_pk_bf16(SN[4], SN[5]); w.w = cvt_pk_bf16(SN[6], SN[7]);
                    *(u32x4*)(rowp + 1024) = w; }
            return;
        }
        if (pn < 2) {
            const int col0 = pn * BM + wc * 32 + 8 * fq;
#pragma unroll
            for (int ai = 0; ai < 2; ++ai)
#pragma unroll
                for (int m = 0; m < 4; ++m) { bf16_t* rowp = Z + (size_t)(row0 + ai * HALF + m * 16) * 4096 + col0;
#pragma unroll
                    for (int bj = 0; bj < 2; ++bj) { const f32x4 v0 = acc[ai][bj][m][0], v1 = acc[ai][bj][m][1];
                        u32x4 w; w.x = cvt_pk_bf16(v0[0], v0[1]); w.y = cvt_pk_bf16(v0[2], v0[3]); w.z = cvt_pk_bf16(v1[0], v1[1]); w.w = cvt_pk_bf16(v1[2], v1[3]);
                        *(u32x4*)(rowp + bj * HALF) = w; } }
            return;
        }
        const int kind = (pn - 2) >> 1, h = 4 * (pn & 1) + wc;
        const int zc = 512 + kind * 512 + h * 64 + 8 * fq;
        const float* gp = kind == 0 ? qg : kg;
        const float qs = kind == 0 ? 0.125f * 1.4426950408889634f : 1.0f;
        f32x4 g0[2], g1[2];
#pragma unroll
        for (int bj = 0; bj < 2; ++bj) { g0[bj] = *(const f32x4*)(gp + 32 * bj + 8 * fq); g1[bj] = *(const f32x4*)(gp + 32 * bj + 8 * fq + 4); }
#pragma unroll
        for (int ai = 0; ai < 2; ++ai)
#pragma unroll
            for (int m = 0; m < 4; ++m) { const int row = row0 + ai * HALF + m * 16;
                f32x4 v[2][2];
#pragma unroll
                for (int bj = 0; bj < 2; ++bj)
#pragma unroll
                    for (int n = 0; n < 2; ++n) v[bj][n] = acc[ai][bj][m][n];
                if (kind < 2) { float ss = 0.f;
#pragma unroll
                    for (int bj = 0; bj < 2; ++bj)
#pragma unroll
                        for (int n = 0; n < 2; ++n) ss += (v[bj][n][0] * v[bj][n][0] + v[bj][n][1] * v[bj][n][1]) + (v[bj][n][2] * v[bj][n][2] + v[bj][n][3] * v[bj][n][3]);
                    ss += __shfl_xor(ss, 16); ss += __shfl_xor(ss, 32);
                    const float rstd = __builtin_amdgcn_rsqf(ss * (1.0f / 64.0f) + 1e-6f);
#pragma unroll
                    for (int bj = 0; bj < 2; ++bj) { v[bj][0] = v[bj][0] * (rstd * qs) * g0[bj]; v[bj][1] = v[bj][1] * (rstd * qs) * g1[bj]; } }
#pragma unroll
                for (int bj = 0; bj < 2; ++bj) { u32x4 w; w.x = cvt_pk_bf16(v[bj][0][0], v[bj][0][1]); w.y = cvt_pk_bf16(v[bj][0][2], v[bj][0][3]); w.z = cvt_pk_bf16(v[bj][1][0], v[bj][1][1]); w.w = cvt_pk_bf16(v[bj][1][2], v[bj][1][3]);
                    *(u32x4*)(Z + (size_t)row * 4096 + zc + 32 * bj) = w; }
                if (kind >= 1 && row < 8192) { float* op = (kind == 1 ? newk : newv) + ((size_t)((row >> 8) * 8 + h) * 256 + (row & 255)) * 64 + 8 * fq;
#pragma unroll
                    for (int bj = 0; bj < 2; ++bj) { *(f32x4*)(op + 32 * bj) = v[bj][0]; *(f32x4*)(op + 32 * bj + 4) = v[bj][1]; } } }
    }
};

template <class Epi, class Sched, bool ALIGN_EPI = false, bool SP2 = false, int MF = 4>
__device__ __forceinline__ void gemm_phase(PG8_LAS unsigned char* lds, const Gemm g, const Sched& S, const Epi& E) {
    const int tid = threadIdx.x, wid = __builtin_amdgcn_readfirstlane(tid >> 6), lane = tid & 63, wr = wid >> 2, wc = wid & 3, fr = lane & 15, fq = lane >> 4;
    const int K = g.K, nt = K / BK;
    unsigned voffA[2], voffB[2];
#pragma unroll
    for (int i = 0; i < 2; ++i) { int R, C; stage_rc(tid * 16 + i * 8192, R, C); const int Rb = Epi::PERM ? ((R & ~31) + perm32(R & 31)) : R;
        const int Ra = MF == 3 ? (48 * (R >> 6) + ((R & 63) < 48 ? (R & 63) : (R & 63) - 16)) : Epi::APERM ? ((R & ~63) + 4 * (R & 15) + ((R >> 4) & 3)) : R;
        voffA[i] = (unsigned)(Ra * K + C) * 2u; voffB[i] = (unsigned)(Rb * K + C) * 2u; }
    const size_t kstep = (size_t)(BK * 2);
    const size_t hstep = (size_t)HALF * K * 2;
    const size_t hstepA = MF == 3 ? (size_t)96 * K * 2 : hstep;
    const size_t tstep = 2 * hstep;
    const unsigned ldsw = (unsigned)wid * 1024u;
    const int aoff = lds_byte(wr * 64 + fr, fq * 8), boff = lds_byte(wc * 32 + fr, fq * 8);
#define PG8_SA(b, h) (((b) * 2 + (h)) * HTB)
#define PG8_SB(b, h) ((4 + (b) * 2 + (h)) * HTB)
#define PG8_STAGE(bufoff, gbase, voff) do { _Pragma("unroll") for (int _i = 0; _i < 2; ++_i) \
        __builtin_amdgcn_global_load_lds((const unsigned*)((const char*)(gbase) + (voff)[_i]), (PG8_LAS unsigned*)(lds + (bufoff) + ldsw + _i * 8192), 16, 0, 0); } while (0)
#define PG8_LDA(dst, b, h) do { _Pragma("unroll") for (int m = 0; m < MF; ++m) _Pragma("unroll") for (int k = 0; k < 2; ++k) dst[m][k] = *(const PG8_LAS bf16x8*)(lds + PG8_SA(b, h) + aoff + m * 2048 + k * 1024); } while (0)
#define PG8_LDB(dst, b, h) do { _Pragma("unroll") for (int n = 0; n < 2; ++n) _Pragma("unroll") for (int k = 0; k < 2; ++k) dst[n][k] = *(const PG8_LAS bf16x8*)(lds + PG8_SB(b, h) + boff + n * 2048 + k * 1024); } while (0)
#define PG8_MMA(ai, bj, At, Bt) do { __builtin_amdgcn_s_setprio(1); _Pragma("unroll") for (int m = 0; m < MF; ++m) _Pragma("unroll") for (int n = 0; n < 2; ++n) _Pragma("unroll") for (int k = 0; k < 2; ++k) \
        acc[ai][bj][m][n] = __builtin_amdgcn_mfma_f32_16x16x32_bf16(Bt[n][k], At[m][k], acc[ai][bj][m][n], 0, 0, 0); __builtin_amdgcn_s_setprio(0); } while (0)
#define PG8_WAIT_V(n) asm volatile("s_waitcnt vmcnt(" #n ")" ::: "memory")
#define PG8_WAIT_L(n) asm volatile("s_waitcnt lgkmcnt(" #n ")" ::: "memory")
#define PG8_BAR __builtin_amdgcn_s_barrier()
#define PG8_SCHED __builtin_amdgcn_sched_barrier(0)
    Unit cur, nxt; int ui = 0;
    if (!S.next(0, cur)) return;
    f32x4 acc[2][2][4][2];
#pragma unroll
    for (int a = 0; a < 2; ++a)
#pragma unroll
        for (int b = 0; b < 2; ++b)
#pragma unroll
            for (int m = 0; m < 4; ++m)
#pragma unroll
                for (int n = 0; n < 2; ++n) acc[a][b][m][n] = (f32x4){0.f, 0.f, 0.f, 0.f};
    bf16x8 At[4][2], B0[2][2], B1[2][2];
    const size_t rowb = (size_t)K * 2; const char* cA = (const char*)g.A + (size_t)cur.arow * rowb; const char* cB = (const char*)g.Bt + (size_t)cur.pn * tstep + cur.bo;
    S.a_ready(cur);
    if constexpr (SP2) {
        PG8_STAGE(PG8_SB(0, 0), cB, voffB); PG8_STAGE(PG8_SB(0, 1), cB + hstep, voffB); PG8_STAGE(PG8_SA(0, 0), cA, voffA); PG8_STAGE(PG8_SA(0, 1), cA + hstepA, voffA);
        if (wr == 1) PG8_BAR;
        PG8_WAIT_V(2); PG8_BAR;
        PG8_STAGE(PG8_SB(1, 0), cB + kstep, voffB); PG8_STAGE(PG8_SA(1, 0), cA + kstep, voffA); PG8_STAGE(PG8_SB(1, 1), cB + hstep + kstep, voffB);
        PG8_WAIT_V(6); PG8_BAR;
    } else {
        PG8_STAGE(PG8_SB(0, 0), cB, voffB); PG8_STAGE(PG8_SA(0, 0), cA, voffA); PG8_STAGE(PG8_SB(0, 1), cB + hstep, voffB); PG8_STAGE(PG8_SA(0, 1), cA + hstepA, voffA);
        if (wr == 1) PG8_BAR;
        PG8_WAIT_V(4); PG8_BAR;
        PG8_STAGE(PG8_SB(1, 0), cB + kstep, voffB); PG8_STAGE(PG8_SA(1, 0), cA + kstep, voffA); PG8_STAGE(PG8_SB(1, 1), cB + hstep + kstep, voffB);
        PG8_WAIT_V(6); PG8_BAR;
    }
    for (;;) {
        const bool has_next = S.next(ui + 1, nxt);
        const char* nA = has_next ? (const char*)g.A + (size_t)nxt.arow * rowb : cA; const char* nB = has_next ? (const char*)g.Bt + (size_t)nxt.pn * tstep + nxt.bo : cB;
        for (int t = 0; t < nt; t += 2) {
            if constexpr (Epi::MIDHOOK) { if (t == nt / 2) E.mid(acc, cur, wr, wc, fr, fq); }
            const bool last = (t == nt - 2);
            const char* a1 = cA + (size_t)(t + 1) * kstep;
            const char* a2 = last ? nA : cA + (size_t)(t + 2) * kstep; const char* b2 = last ? nB : cB + (size_t)(t + 2) * kstep;
            const char* a3 = a2 + kstep; const char* b3 = b2 + kstep;
            if (last && has_next) S.a_ready(nxt);
            if constexpr (SP2) {
            PG8_LDB(B0, 0, 0); PG8_LDB(B1, 0, 1); PG8_SCHED; PG8_LDA(At, 0, 0); PG8_STAGE(PG8_SA(1, 1), a1 + hstepA, voffA);
            PG8_WAIT_V(8); PG8_WAIT_L(0); PG8_BAR; PG8_MMA(0, 0, At, B0); PG8_MMA(0, 1, At, B1); PG8_BAR; PG8_SCHED;
            PG8_LDA(At, 0, 1); PG8_STAGE(PG8_SB(0, 0), b2, voffB); PG8_STAGE(PG8_SB(0, 1), b2 + hstep, voffB); PG8_STAGE(PG8_SA(0, 0), a2, voffA);
            PG8_WAIT_V(8); PG8_WAIT_L(0); PG8_BAR; PG8_MMA(1, 0, At, B0); PG8_MMA(1, 1, At, B1); PG8_BAR; PG8_SCHED;
            PG8_LDB(B0, 1, 0); PG8_LDB(B1, 1, 1); PG8_SCHED; PG8_LDA(At, 1, 0); PG8_STAGE(PG8_SA(0, 1), a2 + hstepA, voffA);
            PG8_WAIT_V(8); PG8_WAIT_L(0); PG8_BAR; PG8_MMA(0, 0, At, B0); PG8_MMA(0, 1, At, B1); PG8_BAR; PG8_SCHED;
            PG8_LDA(At, 1, 1); PG8_STAGE(PG8_SB(1, 0), b3, voffB); PG8_STAGE(PG8_SB(1, 1), b3 + hstep, voffB); PG8_STAGE(PG8_SA(1, 0), a3, voffA);
            PG8_WAIT_V(8); PG8_WAIT_L(0); PG8_BAR; PG8_MMA(1, 0, At, B0); PG8_MMA(1, 1, At, B1); PG8_BAR; PG8_SCHED;
            } else {
            PG8_LDB(B0, 0, 0); PG8_SCHED; PG8_LDA(At, 0, 0); PG8_STAGE(PG8_SA(1, 1), a1 + hstepA, voffA);
            PG8_WAIT_L(8); PG8_BAR; PG8_WAIT_L(0); PG8_MMA(0, 0, At, B0); PG8_BAR; PG8_SCHED;
            PG8_LDB(B1, 0, 1); PG8_STAGE(PG8_SB(0, 0), b2, voffB);
            PG8_BAR; PG8_WAIT_L(0); PG8_MMA(0, 1, At, B1); PG8_BAR;
            PG8_LDA(At, 0, 1); PG8_STAGE(PG8_SA(0, 0), a2, voffA);
            PG8_BAR; PG8_WAIT_L(0); PG8_MMA(1, 0, At, B0); PG8_BAR; PG8_SCHED;
            PG8_STAGE(PG8_SB(0, 1), b2 + hstep, voffB);
            PG8_WAIT_V(6); PG8_BAR; PG8_MMA(1, 1, At, B1); PG8_BAR;
            PG8_LDB(B0, 1, 0); PG8_SCHED; PG8_LDA(At, 1, 0); PG8_STAGE(PG8_SA(0, 1), a2 + hstepA, voffA);
            PG8_WAIT_L(8); PG8_BAR; PG8_WAIT_L(0); PG8_MMA(0, 0, At, B0); PG8_BAR; PG8_SCHED;
            PG8_LDB(B1, 1, 1); PG8_STAGE(PG8_SB(1, 0), b3, voffB);
            PG8_BAR; PG8_WAIT_L(0); PG8_MMA(0, 1, At, B1); PG8_BAR;
            PG8_LDA(At, 1, 1); PG8_STAGE(PG8_SA(1, 0), a3, voffA);
            PG8_BAR; PG8_WAIT_L(0); PG8_MMA(1, 0, At, B0); PG8_BAR; PG8_SCHED;
            PG8_STAGE(PG8_SB(1, 1), b3 + hstep, voffB);
            PG8_WAIT_V(6); PG8_BAR; PG8_MMA(1, 1, At, B1); PG8_BAR;
            }
        }
        if constexpr (ALIGN_EPI) { if (wr == 0) PG8_BAR; }
        if constexpr (!Epi::AFTER_DRAIN) { E(acc, cur, wr, wc, fr, fq); S.done(cur); }
        if (!has_next) break;
#pragma unroll
        for (int a = 0; a < 2; ++a)
#pragma unroll
            for (int b = 0; b < 2; ++b)
#pragma unroll
                for (int m = 0; m < 4; ++m)
#pragma unroll
                    for (int n = 0; n < 2; ++n) acc[a][b][m][n] = (f32x4){0.f, 0.f, 0.f, 0.f};
        cur = nxt; cA = nA; cB = nB; ++ui;
        if constexpr (ALIGN_EPI) { if (wr == 1) PG8_BAR; }
    }
    PG8_WAIT_V(0);
    if constexpr (!ALIGN_EPI) { if (wr == 0) PG8_BAR; }
    PG8_BAR;
    if constexpr (Epi::AFTER_DRAIN) { E.fused(acc, cur, wr, wc, fr, fq, lds, wid, lane); S.done(cur); }
#undef PG8_SA
#undef PG8_SB
#undef PG8_STAGE
#undef PG8_LDA
#undef PG8_LDB
#undef PG8_MMA
#undef PG8_WAIT_V
#undef PG8_WAIT_L
#undef PG8_BAR
#undef PG8_SCHED
}
}
#define GAS __attribute__((address_space(1)))
#define LAS __attribute__((address_space(3)))
typedef unsigned short bf16;
typedef unsigned v4u __attribute__((ext_vector_type(4)));
typedef float f32x4 __attribute__((ext_vector_type(4)));
typedef short bf16x8 __attribute__((ext_vector_type(8)));
typedef GAS unsigned gu32;
typedef GAS unsigned long long gu64;
#define RLX_AGENT __ATOMIC_RELAXED, __HIP_MEMORY_SCOPE_AGENT
#define LDS_WAIT() asm volatile("s_waitcnt lgkmcnt(0)" ::: "memory")
#define VM_WAIT() asm volatile("s_waitcnt vmcnt(0)" ::: "memory")
__device__ __forceinline__ unsigned long long rt() { return __builtin_amdgcn_s_memrealtime(); }
__device__ __forceinline__ unsigned f2bf(float f) { unsigned u = __builtin_bit_cast(unsigned, f); return (u + 0x7fffu + ((u >> 16) & 1u)) >> 16; }
__device__ __forceinline__ unsigned pk2(float lo, float hi) { return f2bf(lo) | (f2bf(hi) << 16); }

#define XB_TMO      128
#define XB_XCNT(j)  (256  + 64 * (j))
#define XB_XSUB(j)  (1280 + 64 * (j))
#define XB_XGEN(j)  (2304 + 64 * (j))
#define XB_TOP      3328
#define XB_TOPGEN   3392
#define XCD_BAR_WORDS 3456
#define XB_SPIN_CAP (1u << 18)

__device__ __forceinline__ unsigned xb_ld(unsigned* p)              { return __hip_atomic_load(p, __ATOMIC_RELAXED, __HIP_MEMORY_SCOPE_AGENT); }
__device__ __forceinline__ unsigned xb_add(unsigned* p, unsigned v) { return __hip_atomic_fetch_add(p, v, __ATOMIC_RELAXED, __HIP_MEMORY_SCOPE_AGENT); }
__device__ __forceinline__ unsigned xb_xcc_id() { return (unsigned)__builtin_amdgcn_s_getreg((3 << 11) | 20) & 0xFu; }
#define XB_SPIN(cond, bar) do { unsigned _sp = 0; while (cond) { __builtin_amdgcn_s_sleep(1); \
    if ((++_sp & 255u) == 0u) { if (xb_ld(&(bar)[XB_TMO])) break; if (_sp > XB_SPIN_CAP) { atomicAdd(&(bar)[XB_TMO], 1u); break; } } } } while (0)

struct XcdBarrier {
    unsigned* bar; unsigned x;
    volatile LAS unsigned* st;
};

__device__ __forceinline__ XcdBarrier xcd_barrier_post(unsigned* bar, volatile LAS unsigned* st) {
    XcdBarrier b; b.bar = bar; b.x = xb_xcc_id(); b.st = st;
    if (threadIdx.x == 0) (void)xb_add(&bar[XB_XCNT(b.x)], 1u);
    return b;
}
__device__ __forceinline__ void xcd_barrier_complete(unsigned* bar, unsigned x, unsigned& nloc, unsigned& nx) {
    const unsigned G = gridDim.x * gridDim.y * gridDim.z;
    unsigned sum, cnt, mine, sp = 0u;
    for (;;) {
        sum = 0u; cnt = 0u; mine = 0u;
#pragma unroll
        for (unsigned j = 0; j < 16; ++j) { const unsigned c = xb_ld(&bar[XB_XCNT(j)]); sum += c; cnt += (c > 0u) ? 1u : 0u; mine = (j == x) ? c : mine; }
        if (sum == G) break;
        __builtin_amdgcn_s_sleep(1);
        if ((++sp & 255u) == 0u) { if (xb_ld(&bar[XB_TMO])) break; if (sp > XB_SPIN_CAP) { atomicAdd(&bar[XB_TMO], 1u); break; } }
    }
    nloc = mine > 0u ? mine : 1u; nx = cnt > 0u ? cnt : 1u;
}

__device__ __forceinline__ void xcd_barrier(const XcdBarrier& b) {
    asm volatile("s_waitcnt vmcnt(0)" ::: "memory");
    __syncthreads();
    if (threadIdx.x == 0) {
        unsigned* bar = b.bar;
        __builtin_amdgcn_s_waitcnt(0);
        unsigned nloc = b.st[0], nx = b.st[1];
        if (nloc == 0u) { xcd_barrier_complete(bar, b.x, nloc, nx); b.st[0] = nloc; b.st[1] = nx; }
        const unsigned old = xb_add(&bar[XB_XSUB(b.x)], 1u);
        const unsigned gen = old / nloc;
        if (old + 1u == (gen + 1u) * nloc) {
            __builtin_amdgcn_fence(__ATOMIC_RELEASE, "agent");
            asm volatile("s_waitcnt vmcnt(0)" ::: "memory");
            const unsigned og = xb_add(&bar[XB_TOP], 1u);
            const unsigned tg = og / nx;
            if (og + 1u == (tg + 1u) * nx) xb_add(&bar[XB_TOPGEN], 1u);
            else XB_SPIN(xb_ld(&bar[XB_TOPGEN]) == tg, bar);
            __builtin_amdgcn_fence(__ATOMIC_ACQUIRE, "agent");
            xb_add(&bar[XB_XGEN(b.x)], 1u);
            asm volatile("s_waitcnt vmcnt(0)" ::: "memory");
        } else {
            XB_SPIN(xb_ld(&bar[XB_XGEN(b.x)]) == gen, bar);
            __builtin_amdgcn_fence(__ATOMIC_ACQUIRE, "agent");
            asm volatile("s_waitcnt vmcnt(0)" ::: "memory");
        }
    }
    __syncthreads();
}
constexpr int NWAVES = 8;
constexpr int DM = 1024, NCTX = 8192, NLAT = 4096, MTOK = NCTX + NLAT, DIN = 4096, DFF = 2816, NUP = 2 * DFF, NMOD = 6 * DM;
constexpr int ZP = 4096;
constexpr float EPS = 1e-6f;
constexpr int NPH = 8;
constexpr size_t MiB = 1u << 20;
constexpr size_t WS_CTL = 0, CTL_ZERO_BYTES = 1 * MiB;
constexpr size_t WS_ROWSS = 128 * 1024;
constexpr size_t WS_BUP = 256 * 1024;
constexpr size_t WS_GM = 384 * 1024;
constexpr size_t WS_MOD = 512 * 1024;
constexpr size_t WS_WIN = 1 * MiB, WS_WP = 9 * MiB, WS_WN = 10 * MiB, WS_WO = 11 * MiB, WS_WUP = 153 * MiB  , WS_WD = 24 * MiB, WS_WPOOL = 30 * MiB;
constexpr size_t WS_CK = 30 * MiB + 512 * 1024, WS_CV = 31 * MiB + 512 * 1024;
constexpr size_t WS_XN = 33 * MiB;
constexpr size_t WS_Z = 57 * MiB;
constexpr size_t WS_U = 57 * MiB;
constexpr size_t WS_X1 = 57 * MiB;
constexpr size_t WS_MN = 189 * MiB, WS_MB = 213 * MiB;
constexpr size_t WS_ACT = 189 * MiB;
constexpr size_t WS_END = 256 * MiB;
static_assert(WS_Z + (size_t)MTOK * ZP * 2 <= WS_WUP && WS_WUP + 3 * (size_t)NUP * DM * 2 <= WS_MN && WS_ACT + (size_t)MTOK * DFF * 2 <= WS_END && WS_MB + (size_t)MTOK * DM * 2 <= WS_END, "ws map");
constexpr int CW_BAR = 4096;
constexpr int RING_OFF = 0, RING_BYTES = 131072;
constexpr int LDSCTL_OFF = RING_BYTES, MISC_OFF = LDSCTL_OFF + 320;
constexpr int UPC_OFF = LDSCTL_OFF + 1024 + 10240;
constexpr int LDS_BYTES = 163840;

#define LAS __attribute__((address_space(3)))
typedef unsigned short bf16;
typedef unsigned v4u __attribute__((ext_vector_type(4)));
typedef unsigned v2u __attribute__((ext_vector_type(2)));
typedef float f32x4 __attribute__((ext_vector_type(4)));
typedef float f32x16 __attribute__((ext_vector_type(16)));
typedef short bf16x8 __attribute__((ext_vector_type(8)));
typedef short s16x4 __attribute__((ext_vector_type(4)));
#define LDS_WAIT() asm volatile("s_waitcnt lgkmcnt(0)" ::: "memory")
using pg8::cvt_pk_bf16; using pg8::bf_lo; using pg8::bf_hi;

struct Args { const float* in[23]; float* out; unsigned char* ws; int ph_lo, ph_hi; };

__device__ __forceinline__ float wave_sum(float v) {
#pragma unroll
    for (int o = 1; o < 64; o <<= 1) v += __shfl_xor(v, o);
    return v;
}
__device__ __forceinline__ float siluf_(float x) { return x * __builtin_amdgcn_rcpf(1.0f + __builtin_amdgcn_exp2f(-1.4426950408889634f * x)); }

struct TrItem { const float* W; bf16* WT; int K, N, k0, n0, drow, bup, kd; };
__device__ __forceinline__ void tr_load(const TrItem& t, int lane, f32x4 (&tv)[8]) {
#pragma unroll
    for (int i = 0; i < 8; ++i) tv[i] = __builtin_nontemporal_load((const f32x4*)(t.W + (size_t)(t.k0 + (lane >> 3) + 8 * i) * t.N + t.n0 + 4 * (lane & 7)));
}
__device__ __forceinline__ void tr_store(const TrItem& t, LAS float* scr, int lane, const f32x4 (&tv)[8]) {
#pragma unroll
    for (int i = 0; i < 8; ++i) { LAS float* p = scr + ((lane >> 3) + 8 * i) * 33 + 4 * (lane & 7); p[0] = tv[i][0]; p[1] = tv[i][1]; p[2] = tv[i][2]; p[3] = tv[i][3]; }
    LDS_WAIT(); asm volatile("" ::: "memory");
    const int c = lane & 7;
#pragma unroll
    for (int j = 0; j < 4; ++j) { const int n = (lane >> 3) + 8 * j; const LAS float* s_ = scr + (8 * c) * 33 + n;
        v4u o; o.x = cvt_pk_bf16(s_[0 * 33], s_[1 * 33]); o.y = cvt_pk_bf16(s_[2 * 33], s_[3 * 33]); o.z = cvt_pk_bf16(s_[4 * 33], s_[5 * 33]); o.w = cvt_pk_bf16(s_[6 * 33], s_[7 * 33]);
        *(v4u*)(t.WT + (size_t)(t.drow + n) * t.K + t.kd + t.k0 + 8 * c) = o; }
    LDS_WAIT(); asm volatile("" ::: "memory");
}
__device__ __forceinline__ void tr_store3(const TrItem& t, LAS float* scr, int lane, const f32x4 (&tv)[8], const LAS float* GM) {
#pragma unroll
    for (int i = 0; i < 8; ++i) { LAS float* p = scr + ((lane >> 3) + 8 * i) * 33 + 4 * (lane & 7); p[0] = tv[i][0]; p[1] = tv[i][1]; p[2] = tv[i][2]; p[3] = tv[i][3]; }
    const int c = lane & 7;
    f32x4 s0[3], s1[3];
#pragma unroll
    for (int v = 0; v < 3; ++v) { s0[v] = *(const LAS f32x4*)(GM + v * DM + t.k0 + 8 * c); s1[v] = *(const LAS f32x4*)(GM + v * DM + t.k0 + 8 * c + 4); }
    LDS_WAIT(); asm volatile("" ::: "memory");
#pragma unroll
    for (int j = 0; j < 4; ++j) { const int n = (lane >> 3) + 8 * j; const LAS float* s_ = scr + (8 * c) * 33 + n;
        const f32x4 x0 = {s_[0 * 33], s_[1 * 33], s_[2 * 33], s_[3 * 33]}, x1 = {s_[4 * 33], s_[5 * 33], s_[6 * 33], s_[7 * 33]};
#pragma unroll
        for (int v = 0; v < 3; ++v) { const f32x4 y0 = x0 * s0[v], y1 = x1 * s1[v];
            v4u o; o.x = cvt_pk_bf16(y0[0], y0[1]); o.y = cvt_pk_bf16(y0[2], y0[3]); o.z = cvt_pk_bf16(y1[0], y1[1]); o.w = cvt_pk_bf16(y1[2], y1[3]);
            *(v4u*)(t.WT + (size_t)v * NUP * DM + (size_t)(t.drow + n) * t.K + t.kd + t.k0 + 8 * c) = o; } }
    LDS_WAIT(); asm volatile("" ::: "memory");
}
__device__ __forceinline__ void tr_bup(const TrItem& t, const LAS float* sfl, float* BUP, int lane, const f32x4 (&tv)[8]) {
    f32x4 b0 = {0.f, 0.f, 0.f, 0.f}, b1 = b0, b2 = b0;
#pragma unroll
    for (int i = 0; i < 8; ++i) { const int k = t.k0 + (lane >> 3) + 8 * i; b0 += tv[i] * sfl[k]; b1 += tv[i] * sfl[DM + k]; b2 += tv[i] * sfl[2 * DM + k]; }
#pragma unroll
    for (int o = 8; o < 64; o <<= 1)
#pragma unroll
        for (int e = 0; e < 4; ++e) { b0[e] += __shfl_xor(b0[e], o); b1[e] += __shfl_xor(b1[e], o); b2[e] += __shfl_xor(b2[e], o); }
    if (lane < 8) { float* p = BUP + t.n0 + 4 * lane;
#pragma unroll
        for (int e = 0; e < 4; ++e) { atomicAdd(p + e, b0[e]); atomicAdd(p + NUP + e, b1[e]); atomicAdd(p + 2 * NUP + e, b2[e]); } }
}
__device__ __forceinline__ void p0_gemv(const Args& a, int gw, int NGW, int wave, int lane) {
    unsigned char* ws = a.ws;
    float* MOD = (float*)(ws + WS_MOD);
    const int gwT = wave * (NGW >> 3) + (gw >> 3);
    for (int t = gwT; t < 96 * 16; t += NGW) {
        const int cg = t % 96, ks = t / 96, col = cg * 64 + lane, k0 = ks * 64;
        const float s0 = siluf_(a.in[5][k0 + lane]), s1 = siluf_(a.in[4][k0 + lane]), s2 = siluf_(a.in[4][1024 + k0 + lane]);
        float a0 = 0.f, a1 = 0.f, a2 = 0.f;
        const float* wp = a.in[8] + (size_t)k0 * NMOD + col;
#pragma unroll
        for (int kh = 0; kh < 64; kh += 32) { float wv[32];
#pragma unroll
            for (int kk = 0; kk < 32; ++kk) wv[kk] = __builtin_nontemporal_load(wp + (size_t)(kh + kk) * NMOD);
#pragma unroll
            for (int kk = 0; kk < 32; ++kk) { a0 += __shfl(s0, kh + kk) * wv[kk]; a1 += __shfl(s1, kh + kk) * wv[kk]; a2 += __shfl(s2, kh + kk) * wv[kk]; } }
        if (ks == 0) { const float b = a.in[9][col]; a0 += b; a1 += b; a2 += b; }
        atomicAdd(MOD + col, a0); atomicAdd(MOD + NMOD + col, a1); atomicAdd(MOD + 2 * NMOD + col, a2);
    }
}
__device__ __forceinline__ void p1_convert(const Args& a, LAS unsigned char* lds, int gw, int NGW, int wave, int lane) {
    unsigned char* ws = a.ws;
    LAS float* scr = (LAS float*)(lds + RING_OFF + wave * 16384);
    const int gwT = wave * (NGW >> 3) + (gw >> 3);
    typedef __attribute__((address_space(4))) const float cfloat_t;
    for (int ft = gwT; ft < 1024; ft += NGW) {
        const int g = ft >> 8, k0 = (ft & 255) * 4;
        cfloat_t* wrow = (cfloat_t*)(a.in[10] + (size_t)k0 * 4096 + g * 128);
        float2 ac[4];
#pragma unroll
        for (int j = 0; j < 4; ++j) ac[j] = make_float2(0.f, 0.f);
        const float* pw = a.in[13] + (size_t)g * 128 * 128 + 2 * lane;
#pragma unroll 16
        for (int c = 0; c < 128; ++c) { const float2 w2 = *(const float2*)(pw + (size_t)c * 128);
#pragma unroll
            for (int j = 0; j < 4; ++j) { const float wv = wrow[j * 4096 + c]; ac[j].x += wv * w2.x; ac[j].y += wv * w2.y; } }
        const float2 sp = *(const float2*)(a.in[14] + g * 128 + 2 * lane);
        bf16* wt = (bf16*)(ws + WS_WIN) + (size_t)(g * 128 + 2 * lane) * 1024 + k0;
        v2u o; o.x = cvt_pk_bf16(ac[0].x * sp.x, ac[1].x * sp.x); o.y = cvt_pk_bf16(ac[2].x * sp.x, ac[3].x * sp.x);
        *(v2u*)wt = o;
        o.x = cvt_pk_bf16(ac[0].y * sp.y, ac[1].y * sp.y); o.y = cvt_pk_bf16(ac[2].y * sp.y, ac[3].y * sp.y);
        *(v2u*)(wt + 1024) = o;
    }
    constexpr int I_IN = 16 * 112, I_P = 8 * 32, NITEMS = I_IN + 2 * I_P;
#define P1_DECODE(T, it_) do { int r = (it_); \
        if (r < I_IN) { const int kb = r / 112, nb = 16 + r % 112, n0 = nb * 32, pn = n0 >> 8, lc = n0 & 255;   \
            T = TrItem{a.in[10], (bf16*)(ws + WS_WIN), 1024, 4096, kb * 64, n0, (pn >= 2 && pn < 8) ? 256 * pn + 128 * ((lc & 63) >> 5) + 32 * (lc >> 6) : (pn >= 8 ? 2048 + 256 * (((n0 - 2048) & 1023) >> 7) + 128 * (n0 >= 3072) + (n0 & 127) : n0), 0, 0}; }   \
        else { r -= I_IN; const int w_ = r >= I_P; r -= w_ * I_P; const int kb = r / 32, nb = r % 32; T = TrItem{a.in[16 + w_], (bf16*)(ws + WS_WP), 1024, 1024, kb * 64, nb * 32, nb * 32, 0, w_ * 512}; } } while (0)
    for (int it = NGW - 1 - gw; it < NITEMS; it += 2 * NGW) {
        TrItem A, B; f32x4 ta[8], tb[8]; const bool hasB = it + NGW < NITEMS;
        P1_DECODE(A, it); tr_load(A, lane, ta);
        if (hasB) { P1_DECODE(B, it + NGW); tr_load(B, lane, tb); }
        tr_store(A, scr, lane, ta);
        if (hasB) tr_store(B, scr, lane, tb);
    }
#undef P1_DECODE
    for (int i = gw * 64 + lane; i < 2 * 65536; i += NGW * 64) {
        const int t = i >> 16, e = (i & 65535) * 8; const float* src = a.in[2 + t] + e;
        const f32x4 x0 = __builtin_nontemporal_load((const f32x4*)src), x1 = __builtin_nontemporal_load((const f32x4*)(src + 4));
        v4u o; o.x = cvt_pk_bf16(x0[0], x0[1]); o.y = cvt_pk_bf16(x0[2], x0[3]); o.z = cvt_pk_bf16(x1[0], x1[1]); o.w = cvt_pk_bf16(x1[2], x1[3]);
        *(v4u*)((bf16*)(ws + (t ? WS_CV : WS_CK)) + e) = o;
    }
}

constexpr int H_O = 16 * 32, H_UP = 16 * 176, H_D = 44 * 32, HITEMS = H_O + H_UP + H_D, HSPLIT = 1024;
__device__ __forceinline__ void late_items(const Args& a, LAS unsigned char* lds, int lo, int hi, int hw, int NHW, int wave, int lane) {
    LAS float* scr = (LAS float*)(lds + RING_OFF + wave * 8448);
    LAS float* sfl = (LAS float*)(lds + RING_OFF + 69632); LAS float* gml = sfl + 3 * DM;
    const float* MOD = (const float*)(a.ws + WS_MOD); float* BUP = (float*)(a.ws + WS_BUP); const float* GM = (const float*)(a.ws + WS_GM);
    int e0 = wave * 64 + lane; asm volatile("" : "+v"(e0));
    for (int e = e0; e < 3 * DM; e += NWAVES * 64) { sfl[e] = MOD[(e >> 10) * NMOD + 3 * DM + (e & 1023)]; gml[e] = GM[e]; }
    __syncthreads();
#define H_DECODE(T, it_) do { int r = (it_); \
        if (r < H_O) { const int kb = r / 32, nb = r % 32; T = TrItem{a.in[18], (bf16*)(a.ws + WS_WO), 1024, 1024, kb * 64, nb * 32, nb * 32, 0, 0}; } \
        else if (r < H_O + H_UP) { r -= H_O; const int kb = r / 176, nb = r % 176, n0 = nb * 32;   \
            T = TrItem{a.in[19], (bf16*)(a.ws + WS_WUP), 1024, NUP, kb * 64, n0, n0 < DFF ? 256 * (n0 / 128) + (n0 % 128) : 256 * ((n0 - DFF) / 128) + 128 + ((n0 - DFF) % 128), 1, 0}; } \
        else { r -= H_O + H_UP; const int kb = r / 32, nb = r % 32; T = TrItem{a.in[22], (bf16*)(a.ws + WS_WD), DFF, 1024, kb * 64, nb * 32, nb * 32, 0, 0}; } } while (0)
#define H_STEP(CUR, tcur, NXT, tnxt, itn) do { if ((itn) < hi) { H_DECODE(NXT, (itn)); tr_load(NXT, lane, tnxt); } \
        if (CUR.bup) { tr_bup(CUR, sfl, BUP, lane, tcur); tr_store3(CUR, scr, lane, tcur, gml); } else tr_store(CUR, scr, lane, tcur); } while (0)
    int it = lo + hw;
    if (it < hi) {
        TrItem A, B, C, D; f32x4 ta[8], tb[8], tc[8], td[8];
        H_DECODE(A, it); tr_load(A, lane, ta);
        if (it + NHW < hi) { H_DECODE(B, it + NHW); tr_load(B, lane, tb); }
        if (it + 2 * NHW < hi) { H_DECODE(C, it + 2 * NHW); tr_load(C, lane, tc); }
        for (;;) {
            H_STEP(A, ta, D, td, it + 3 * NHW); it += NHW; if (it >= hi) break;
            H_STEP(B, tb, A, ta, it + 3 * NHW); it += NHW; if (it >= hi) break;
            H_STEP(C, tc, B, tb, it + 3 * NHW); it += NHW; if (it >= hi) break;
            H_STEP(D, td, C, tc, it + 3 * NHW); it += NHW; if (it >= hi) break;
        }
    }
#undef H_STEP
    __syncthreads();
#undef H_DECODE
}
template <int R> __device__ __forceinline__ void modnorm_rows(const float* x0, const float* x1, bf16* XNo, const float* g, const float* MODp, int sh, int m0, int stride, int lane) {
    f32x4 v[R][4]; float ss[R];
#pragma unroll
    for (int i = 0; i < R; ++i) { const int m = m0 + i * stride, mc = m < MTOK ? m : m0; const float* xr = mc < NCTX ? x0 + (size_t)mc * DM : x1 + (size_t)(mc - NCTX) * DM;
#pragma unroll
        for (int j = 0; j < 4; ++j) v[i][j] = __builtin_nontemporal_load((const f32x4*)(xr + 256 * j + 4 * lane)); }
#pragma unroll
    for (int i = 0; i < R; ++i) { float s = 0.f;
#pragma unroll
        for (int j = 0; j < 4; ++j) s += (v[i][j][0] * v[i][j][0] + v[i][j][1] * v[i][j][1]) + (v[i][j][2] * v[i][j][2] + v[i][j][3] * v[i][j][3]);
        ss[i] = s; }
#pragma unroll
    for (int o = 1; o < 64; o <<= 1) {
#pragma unroll
        for (int i = 0; i < R; ++i) ss[i] += __shfl_xor(ss[i], o); }
#pragma unroll
    for (int i = 0; i < R; ++i) { const int m = m0 + i * stride; if (m < MTOK) {
        const float rstd = 1.0f / sqrtf(ss[i] * (1.f / DM) + EPS); const float* modv = MODp + (m < NCTX ? 0 : 1 + ((m - NCTX) >> 11)) * NMOD;
#pragma unroll
        for (int j = 0; j < 4; ++j) { const int c = 256 * j + 4 * lane;
            const f32x4 gg = *(const f32x4*)(g + c), shf = *(const f32x4*)(modv + sh * 1024 + c), scl = *(const f32x4*)(modv + (sh + 1) * 1024 + c);
            const f32x4 y = v[i][j] * rstd * gg * (scl + 1.0f) + shf;
            v2u o; o.x = cvt_pk_bf16(y[0], y[1]); o.y = cvt_pk_bf16(y[2], y[3]);
            *(v2u*)(XNo + (size_t)m * DM + c) = o; } } }
}


typedef short v4i16_t __attribute__((ext_vector_type(4)));
__device__ __forceinline__ s16x4 vtr(const LAS unsigned char* p) { return __builtin_bit_cast(s16x4, __builtin_amdgcn_ds_read_tr16_b64_v4i16((LAS v4i16_t*)p)); }
constexpr int VS = 144;
constexpr float NEGBIG = -1e30f;
__device__ __forceinline__ int clampi(int x, int lo, int hi) { return x < lo ? lo : (x > hi ? hi : x); }

__device__ __forceinline__ void attn_task(const Args& a, LAS unsigned char* vl, bool latent, int id, int lane) {
    const bf16* Z = (const bf16*)(a.ws + WS_Z);
    const bf16* CK = (const bf16*)(a.ws + WS_CK); const bf16* CV = (const bf16*)(a.ws + WS_CV);
    bf16* NA = (bf16*)(a.ws + WS_MN);
    const int r32 = lane & 31, hi = lane >> 5;
    int b, h, qtok, nblk, qrow = 0, qcol = 0, rlo = 0, bs = 0;
    if (!latent) { const int qb = id & 7; h = (id >> 3) & 7; b = id >> 6; qtok = b * 256 + qb * 32 + r32; nblk = 8; }
    else { const int nq = id & 3, rp = (id >> 2) & 15; h = (id >> 6) & 7; b = id >> 9; qrow = 2 * rp + (r32 >> 4); qcol = 16 * nq + (r32 & 15); qtok = NCTX + b * 2048 + qrow * 64 + qcol;
        rlo = clampi(2 * rp - 4, 0, 24); const int rhi = clampi(2 * rp - 3, 0, 24) + 7; bs = clampi(16 * nq - 8, 0, 32); nblk = 16 + (rhi - rlo + 1); }
    const int rs_q = clampi(qrow - 4, 0, 24), ws_q = clampi(qcol - 8, 0, 48);
    constexpr float L2E = 1.4426950408889634f;
    LAS float* tab = (LAS float*)(vl + 9216);
    if (latent) { const float* rpb = a.in[15] + h * (15 * 31);
#pragma unroll
        for (int i = 0; i < 8; ++i) { const int e = i * 64 + lane; tab[e] = e < 465 ? rpb[e] * L2E : 0.f; } }
    unsigned okc = 0u;
#pragma unroll
    for (int i = 0; i < 16; ++i) { const int kc = bs + (i & 3) + 8 * (i >> 2) + 4 * hi; okc |= ((kc >= ws_q) && (kc < ws_q + 16)) ? (1u << i) : 0u; }
    const int dcb = bs + 4 * hi - qcol + 15;
    bf16x8 qf[4];
#pragma unroll
    for (int s = 0; s < 4; ++s) qf[s] = *(const bf16x8*)(Z + (size_t)qtok * ZP + 512 + h * 64 + 16 * s + 8 * hi);
    constexpr float ATT_THR = 8.0f;
    float mrun = 0.f, lrun = 0.f;
    f32x16 negm = {};
    f32x16 o0 = {}, o1 = {};
    v4u kA[4], kB[4]; v4u vA[4], vB[4];
#define ATT_LOAD(KS, VS_, t) do { const bf16* kp_; const bf16* vp_; int pitch_; \
        if (latent && (t) < 16) { const size_t o_ = ((size_t)(b * 8 + h) * 512 + 32 * (t)) * 64; kp_ = CK + o_; vp_ = CV + o_; pitch_ = 64; } \
        else { const int tok_ = latent ? NCTX + b * 2048 + (rlo + (t) - 16) * 64 + bs : b * 256 + 32 * (t); kp_ = Z + (size_t)tok_ * ZP + 1024 + h * 64; vp_ = kp_ + 512; pitch_ = ZP; } \
        _Pragma("unroll") for (int i = 0; i < 4; ++i) { const int c_ = i * 64 + lane; KS[i] = *(const v4u*)(kp_ + (size_t)(c_ >> 3) * pitch_ + (c_ & 7) * 8); VS_[i] = *(const v4u*)(vp_ + (size_t)(c_ >> 3) * pitch_ + (c_ & 7) * 8); } } while (0)
    const int li = lane & 15;
    const LAS unsigned char* vrd = vl + (4 * hi + (li >> 2)) * VS + (16 * ((lane >> 4) & 1) + 4 * (li & 3)) * 2;
#define ATT_BLOCK(KS, VS_, t, tn, DO_LOAD) do { \
        _Pragma("unroll") for (int i = 0; i < 4; ++i) { const int c_ = i * 64 + lane; *(LAS v4u*)(vl + (c_ >> 3) * VS + (c_ & 7) * 16) = VS_[i]; *(LAS v4u*)(vl + 4608 + (c_ >> 3) * VS + (c_ & 7) * 16) = KS[i]; } \
        bf16x8 kf_[4]; \
        _Pragma("unroll") for (int k = 0; k < 4; ++k) kf_[k] = *(const LAS bf16x8*)(vl + 4608 + r32 * VS + 32 * k + 16 * hi); \
        f32x16 s = negm;                                     \
        _Pragma("unroll") for (int k = 0; k < 4; ++k) s = __builtin_amdgcn_mfma_f32_32x32x16_bf16(kf_[k], qf[k], s, 0, 0, 0); \
        asm volatile("" ::: "memory"); \
        if (DO_LOAD) ATT_LOAD(KS, VS_, (tn)); \
        const bool loc = latent && (t) >= 16; \
        float x[16]; float bm = NEGBIG; \
        if (loc) { const int kr = rlo + (t) - 16; const bool okr = (kr >= rs_q) && (kr < rs_q + 8); \
            const LAS float* tb = tab + (kr - qrow + 7) * 31 + dcb; \
            _Pragma("unroll") for (int i = 0; i < 16; ++i) { const float bias = tb[(i & 3) + 8 * (i >> 2)]; \
                const float v = (okr && ((okc >> i) & 1u)) ? s[i] + bias : NEGBIG; x[i] = v; bm = fmaxf(bm, v); } } \
        else { _Pragma("unroll") for (int i = 0; i < 16; ++i) { x[i] = s[i]; bm = fmaxf(bm, s[i]); } } \
        bm = fmaxf(bm, __shfl_xor(bm, 32)); \
        if ((t) == 0 || __any(bm > ATT_THR)) {                  \
            const float d = (t) == 0 ? bm : fmaxf(bm, 0.f), alpha = (t) == 0 ? 1.0f : __builtin_amdgcn_exp2f(-d); \
            mrun += d; lrun *= alpha; \
            _Pragma("unroll") for (int i = 0; i < 16; ++i) { x[i] -= d; o0[i] *= alpha; o1[i] *= alpha; negm[i] = -mrun; } } \
        float ps = 0.f; \
        _Pragma("unroll") for (int i = 0; i < 16; ++i) { x[i] = __builtin_amdgcn_exp2f(x[i]); ps += x[i]; } \
        lrun += ps; \
        bf16x8 pf[2]; \
        _Pragma("unroll") for (int sp = 0; sp < 2; ++sp) { v4u w; w.x = cvt_pk_bf16(x[8 * sp + 0], x[8 * sp + 1]); w.y = cvt_pk_bf16(x[8 * sp + 2], x[8 * sp + 3]); w.z = cvt_pk_bf16(x[8 * sp + 4], x[8 * sp + 5]); w.w = cvt_pk_bf16(x[8 * sp + 6], x[8 * sp + 7]); pf[sp] = __builtin_bit_cast(bf16x8, w); } \
        _Pragma("unroll") for (int sp = 0; sp < 2; ++sp) { \
            const s16x4 l0 = vtr(vrd + (16 * sp) * VS), h0 = vtr(vrd + (16 * sp + 8) * VS), l1 = vtr(vrd + (16 * sp) * VS + 64), h1 = vtr(vrd + (16 * sp + 8) * VS + 64); \
            const bf16x8 v0 = (bf16x8){l0[0], l0[1], l0[2], l0[3], h0[0], h0[1], h0[2], h0[3]}, v1 = (bf16x8){l1[0], l1[1], l1[2], l1[3], h1[0], h1[1], h1[2], h1[3]}; \
            o0 = __builtin_amdgcn_mfma_f32_32x32x16_bf16(v0, pf[sp], o0, 0, 0, 0); \
            o1 = __builtin_amdgcn_mfma_f32_32x32x16_bf16(v1, pf[sp], o1, 0, 0, 0); } \
        asm volatile("" ::: "memory"); } while (0)
    ATT_LOAD(kA, vA, 0); ATT_LOAD(kB, vB, 1);
    const int npair = nblk >> 1, lastb = nblk - 1;
#define ATT_PAIR(t_) do { const int t = (t_); ATT_BLOCK(kA, vA, t, (t + 2 < lastb ? t + 2 : lastb), true); ATT_BLOCK(kB, vB, t + 1, (t + 3 < lastb ? t + 3 : lastb), true); } while (0)
    int p = 0;
    for (; p < npair; ++p) ATT_PAIR(2 * p);
#undef ATT_PAIR
    if (nblk & 1) ATT_BLOCK(kA, vA, lastb, lastb, false);
#undef ATT_LOAD
#undef ATT_BLOCK
    const float inv = 1.0f / (lrun + __shfl_xor(lrun, 32));
    const int otok = latent ? qtok : (qtok & ~255) + 2 * (qtok & 127) + ((qtok >> 7) & 1);
    bf16* op = NA + (size_t)otok * 1024 + 512 + h * 64 + 4 * hi;
#pragma unroll
    for (int g = 0; g < 4; ++g) {
        v2u w0; w0.x = cvt_pk_bf16(o0[4 * g] * inv, o0[4 * g + 1] * inv); w0.y = cvt_pk_bf16(o0[4 * g + 2] * inv, o0[4 * g + 3] * inv);
        v2u w1; w1.x = cvt_pk_bf16(o1[4 * g] * inv, o1[4 * g + 1] * inv); w1.y = cvt_pk_bf16(o1[4 * g + 2] * inv, o1[4 * g + 3] * inv);
        *(v2u*)(op + 8 * g) = w0; *(v2u*)(op + 32 + 8 * g) = w1;
    }
}

template <int GI> struct PoolQuad { v4u w[2 << GI]; };
template <int GI> __device__ __forceinline__ void pool_load(const Args& a, int tq, int lane, PoolQuad<GI>& q) {
    const bf16* Z = (const bf16*)(a.ws + WS_Z);
    constexpr int half = 1 << GI;
    const int tok = 4 * tq + (lane >> 4), col = GI * 128 + 8 * (lane & 15);
    const int L = tok < NCTX ? 256 : 2048, s0 = tok < NCTX ? (tok & ~255) : NCTX + ((tok - NCTX) & ~2047), tpos = tok - s0;
#pragma unroll
    for (int o = 0; o < 2 * half; ++o) { const int tp = tpos - half + o; const int tpc = (tp >= 0 && tp < L) ? tp : tpos; q.w[o] = *(const v4u*)(Z + col + (size_t)(s0 + tpc) * ZP); }
}
template <int GI> __device__ __forceinline__ void pool_finish(const Args& a, int tq, int lane, const PoolQuad<GI>& q) {
    bf16* MIX = (bf16*)(a.ws + WS_MN);
    constexpr int half = 1 << GI;
    const int tok = 4 * tq + (lane >> 4), col = GI * 128 + 8 * (lane & 15);
    const int L = tok < NCTX ? 256 : 2048, s0 = tok < NCTX ? (tok & ~255) : NCTX + ((tok - NCTX) & ~2047), tpos = tok - s0;
    const int lo = tpos - half < 0 ? 0 : tpos - half, hi = tpos + half > L ? L : tpos + half;
    const float rc = 1.0f / (float)(hi - lo);
    float sum[8];
#pragma unroll
    for (int e = 0; e < 8; ++e) sum[e] = 0.f;
#pragma unroll
    for (int o = 0; o < 2 * half; ++o) { const int tp = tpos - half + o; const float mk = (tp >= 0 && tp < L) ? 1.f : 0.f;
        sum[0] += mk * bf_lo(q.w[o].x); sum[1] += mk * bf_hi(q.w[o].x); sum[2] += mk * bf_lo(q.w[o].y); sum[3] += mk * bf_hi(q.w[o].y);
        sum[4] += mk * bf_lo(q.w[o].z); sum[5] += mk * bf_hi(q.w[o].z); sum[6] += mk * bf_lo(q.w[o].w); sum[7] += mk * bf_hi(q.w[o].w); }
    const v4u c = q.w[half];
    v4u p; p.x = cvt_pk_bf16(sum[0] * rc - bf_lo(c.x), sum[1] * rc - bf_hi(c.x)); p.y = cvt_pk_bf16(sum[2] * rc - bf_lo(c.y), sum[3] * rc - bf_hi(c.y));
    p.z = cvt_pk_bf16(sum[4] * rc - bf_lo(c.z), sum[5] * rc - bf_hi(c.z)); p.w = cvt_pk_bf16(sum[6] * rc - bf_lo(c.w), sum[7] * rc - bf_hi(c.w));
    *(v4u*)(MIX + (size_t)tok * 1024 + col) = p;
}
template <int GI> __device__ __forceinline__ void pool_run3(const Args& a, int tq0, int lane) {
    PoolQuad<GI> qa, qb;
    pool_load<GI>(a, tq0, lane, qa); pool_load<GI>(a, tq0 + 1, lane, qb);
    asm volatile("" ::: "memory");
    pool_finish<GI>(a, tq0, lane, qa);
    pool_load<GI>(a, tq0 + 2, lane, qa);
    asm volatile("" ::: "memory");
    pool_finish<GI>(a, tq0 + 1, lane, qb);
    pool_finish<GI>(a, tq0 + 2, lane, qa);
}

__global__ void __launch_bounds__(NWAVES * 64, 2) fwd_kernel(Args args) {
    extern __shared__ __attribute__((aligned(16))) unsigned char lds_raw[];
    LAS unsigned char* lds = (LAS unsigned char*)lds_raw;
    volatile LAS unsigned* MISC = (volatile LAS unsigned*)(lds + MISC_OFF);
    const int tid = threadIdx.x, lane = tid & 63, wave = __builtin_amdgcn_readfirstlane(tid >> 6);
    const int G = gridDim.x, bx = blockIdx.x, vcu = (G % 8 == 0) ? (bx % 8) * (G / 8) + bx / 8 : bx;
    const int gw = vcu * NWAVES + wave, NGW = G * NWAVES;
    unsigned char* ws = args.ws;
    for (int u = tid; u < (LDS_BYTES - LDSCTL_OFF) / 4; u += NWAVES * 64) ((LAS unsigned*)(lds + LDSCTL_OFF))[u] = 0u;
    __syncthreads();
#if MK_PER_PHASE
#define GRID_BAR() do { } while (0)
#else
    XcdBarrier bar = xcd_barrier_post((unsigned*)(ws + WS_CTL) + CW_BAR, MISC + 8);
#define GRID_BAR() xcd_barrier(bar)
#endif
    const int lo = args.ph_lo, hi = args.ph_hi;
#define IN(k) (lo <= (k) && (k) < hi)
#define SEAM(k) do { if (IN(k) && IN((k) + 1)) GRID_BAR(); } while (0)
    const float* MOD = (const float*)(ws + WS_MOD);
    bf16* XN = (bf16*)(ws + WS_XN); bf16* Zb = (bf16*)(ws + WS_Z);
    float* Y = args.out;

    if (IN(0)) { p0_gemv(args, gw, NGW, wave, lane); } SEAM(0);
    if (IN(1)) {
        if (gw < 48) { const int e = gw * 64 + lane, v = e >> 10, k = e & 1023; ((float*)(ws + WS_GM))[e] = args.in[7][k] * (1.0f + MOD[v * NMOD + 4 * DM + k]); }
        p1_convert(args, lds, gw, NGW, wave, lane);
        for (int m0 = gw; m0 < MTOK; m0 += 6 * NGW) modnorm_rows<6>(args.in[0], args.in[1], XN, args.in[6], MOD, 0, m0, NGW, lane); } SEAM(1);
    if (IN(2)) { pg8::Gemm g{XN, (const bf16*)(ws + WS_WIN), MTOK, DIN, DM}; pg8::StaticOrder S; S.init(MTOK, DIN, G, bx);
        pg8::EpiQKV E{Zb, args.in[11], args.in[12], Y + (size_t)MTOK * DM, Y + (size_t)MTOK * DM + (size_t)NCTX * 512}; pg8::gemm_phase<pg8::EpiQKV, pg8::StaticOrder, true, true>(lds + RING_OFF, g, S, E); } SEAM(2);
    if (IN(3)) {
        LAS unsigned char* vl = lds + RING_OFF + wave * 16384;
        if (wave < 4) { for (int id = vcu * 4 + wave; id < 1024; id += G * 4) attn_task(args, vl, true, id, lane); }
        else { for (int id = vcu * 4 + (wave - 4); id < 1024; id += G * 4) { attn_task(args, vl, false, 2 * id, lane); attn_task(args, vl, false, 2 * id + 1, lane); } }
        for (int tb = vcu * 12; tb < MTOK / 4; tb += G * 12) { const int tq0 = tb + 3 * (wave & 3);
            if (wave < 4) { pool_run3<0>(args, tq0, lane); pool_run3<1>(args, tq0, lane); } else { pool_run3<2>(args, tq0, lane); pool_run3<3>(args, tq0, lane); } }
    } SEAM(3);
    const bool helper = G > 192 ? bx >= 192 : true; const int NHW = (G > 192 ? G - 192 : G) * NWAVES, hw = (G > 192 ? bx - 192 : bx) * NWAVES + wave;
    if (IN(4)) {
        if (helper) late_items(args, lds, 0, HSPLIT, hw, NHW, wave, lane);
        { pg8::Gemm g{(const bf16*)(ws + WS_MN), (const bf16*)(ws + WS_WP), MTOK, DM, DM}; pg8::StaticOrder S; S.init(MTOK, DM, G, bx);
          pg8::EpiMerge E{Zb, (bf16*)(ws + WS_MB)}; pg8::gemm_phase<pg8::EpiMerge, pg8::StaticOrder, true, true>(lds + RING_OFF, g, S, E); }
    } SEAM(4);
    if (IN(5)) { if (helper) late_items(args, lds, HSPLIT, HITEMS, hw, NHW, wave, lane);
        pg8::Gemm g{(const bf16*)(ws + WS_MB), (const bf16*)(ws + WS_WO), MTOK, DM, DM}; pg8::StaticOrder S; S.init(MTOK, DM, G, bx);
        pg8::EpiResidNorm E{args.in[0], args.in[1], (bf16*)(ws + WS_X1), MOD + 2 * DM, (float*)(ws + WS_ROWSS)}; pg8::gemm_phase<pg8::EpiResidNorm, pg8::StaticOrder, true, true>(lds + RING_OFF, g, S, E); } SEAM(5);
    if (IN(6)) { pg8::Gemm g{(const bf16*)(ws + WS_X1), (const bf16*)(ws + WS_WUP), 50 * 256, NUP, DM};
        pg8::UpOrder S; S.init(50 * 256, NUP, G, bx); S.ctl = (const float*)(ws + WS_CTL); S.cw = args.in[20]; S.cb = args.in[21]; S.cbuf = (LAS float*)(lds + UPC_OFF);
        pg8::EpiConvGate E{(bf16*)(ws + WS_ACT), (LAS float*)(lds + LDSCTL_OFF + 1024)};
        pg8::gemm_phase<pg8::EpiConvGate, pg8::UpOrder, true, true>(lds + RING_OFF, g, S, E); } SEAM(6);
    if (IN(7)) { pg8::Gemm g{(const bf16*)(ws + WS_ACT), (const bf16*)(ws + WS_WD), MTOK, DM, DFF}; pg8::StaticOrder S; S.init(MTOK, DM, G, bx, 192);
        pg8::EpiResid3 E{Y, MOD + 5 * DM, (const bf16*)(ws + WS_X1)}; pg8::gemm_phase<pg8::EpiResid3, pg8::StaticOrder, true, true, 3>(lds + RING_OFF, g, S, E); }
#undef IN
#undef SEAM
}

extern "C" void kernel_launch(void* const* d_in, const int* in_sizes, int n_in, void* d_out, int out_size, void* d_ws, size_t ws_size, hipStream_t stream) {
    static int grid = 0;
    if (grid == 0) {
        if (n_in != 23 || ws_size < WS_END) { fprintf(stderr, "kernel_launch: unexpected n_in %d / ws %zu\n", n_in, ws_size); grid = -1; return; }
        int dev = 0, cus = 0, per_cu = 0;
        if (hipGetDevice(&dev) != hipSuccess || hipDeviceGetAttribute(&cus, hipDeviceAttributeMultiprocessorCount, dev) != hipSuccess) { grid = -1; return; }
        if (hipFuncSetAttribute((const void*)fwd_kernel, hipFuncAttributeMaxDynamicSharedMemorySize, LDS_BYTES) != hipSuccess) { fprintf(stderr, "kernel_launch: hipFuncSetAttribute failed\n"); grid = -1; return; }
        if (hipOccupancyMaxActiveBlocksPerMultiprocessor(&per_cu, (const void*)fwd_kernel, NWAVES * 64, LDS_BYTES) != hipSuccess || per_cu < 1) { fprintf(stderr, "kernel_launch: occupancy query says %d\n", per_cu); (void)hipGetLastError(); grid = -1; return; }
        grid = cus;
        if (grid % 8) grid -= grid % 8;
    }
    if (grid < 0) return;
    (void)hipMemsetAsync((char*)d_ws + WS_CTL, 0, CTL_ZERO_BYTES, stream);
    Args a{};
    for (int i = 0; i < 23; ++i) a.in[i] = (const float*)d_in[i];
    a.out = (float*)d_out; a.ws = (unsigned char*)d_ws;
#if MK_PER_PHASE
    for (int p = 0; p < NPH; ++p) { a.ph_lo = p; a.ph_hi = p + 1; hipLaunchKernelGGL(fwd_kernel, dim3(grid), dim3(NWAVES * 64), LDS_BYTES, stream, a); }
#else
    a.ph_lo = 0; a.ph_hi = NPH;
    hipLaunchKernelGGL(fwd_kernel, dim3(grid), dim3(NWAVES * 64), LDS_BYTES, stream, a);
#endif
}
```
